# Optimizing an MI355X kernel written in HIP

```python
import math
import jax
import jax.numpy as jnp
from jax import lax
import numpy as np

D_MODEL = 1024
BATCH = 1
SEQ = 16384
DEPTH = 4

GRID_W = 64
CTX_LEN = 256
N_MIXERS = 3
N_HEADS = 16
N_KV_HEADS = 4
HEAD_DIM = 64
Q_PER_KV = N_HEADS // N_KV_HEADS
WINDOW = 128
ATTN_BLOCK = 128
ATTN_SCALE = HEAD_DIM ** -0.5
ROPE_BASE = 10000.0
ROPE_FREQS = HEAD_DIM // 4
CHUNK = 128
GMLP_WIDTH = D_MODEL
GMLP_GROUPS = 8
GMLP_GROUP_DIM = GMLP_WIDTH // GMLP_GROUPS
CONV_WIDTH = 3
N_EXPERTS = 16
N_EXPERT_GROUPS = 4
EXPERTS_PER_GROUP = N_EXPERTS // N_EXPERT_GROUPS
TOP_K = 2
D_EXPERT = 512
MOE_BLOCK = 128
ALPHA = (2 * DEPTH) ** 0.25
BETA = (8 * DEPTH) ** -0.25
LN_EPS = 1e-5

kernel_name = "hybrid_dit_interleaved_moe"


def layer_norm(x, g, b):
    xf = x.astype(jnp.float32)
    mu = jnp.mean(xf, axis=-1, keepdims=True)
    var = jnp.mean(jnp.square(xf - mu), axis=-1, keepdims=True)
    y = (xf - mu) * lax.rsqrt(var + LN_EPS) * g.astype(jnp.float32) + b.astype(jnp.float32)
    return y.astype(x.dtype)


def modulate(h, shift, scale):
    return h * (1 + scale) + shift


def axial_rope_tables(L, dtype):
    rows = L // GRID_W
    row = jnp.repeat(jnp.arange(rows), GRID_W).astype(jnp.float32)
    col = jnp.tile(jnp.arange(GRID_W), rows).astype(jnp.float32)
    freqs = jnp.power(ROPE_BASE, -jnp.arange(ROPE_FREQS, dtype=jnp.float32) / ROPE_FREQS)
    ar = row[:, None] * freqs[None, :]
    ac = col[:, None] * freqs[None, :]
    ang = jnp.concatenate([ar, ar, ac, ac], axis=-1)
    return jnp.cos(ang).astype(dtype), jnp.sin(ang).astype(dtype)


def apply_axial_rope(x, cos, sin):
    L = x.shape[1]
    bshape = (1, L) + (1,) * (x.ndim - 3) + (HEAD_DIM,)
    xr = x.reshape(x.shape[:-1] + (2, 2, ROPE_FREQS))
    rot = jnp.stack([-xr[..., 1, :], xr[..., 0, :]], axis=-2).reshape(x.shape)
    return x * cos.reshape(bshape) + rot * sin.reshape(bshape)


def qkv_project(h, w_qkv, with_q):
    B, L, _ = h.shape
    qd = N_HEADS * HEAD_DIM
    kd = N_KV_HEADS * HEAD_DIM
    if with_q:
        y = h @ w_qkv
        q = y[..., :qd].reshape(B, L, N_KV_HEADS, Q_PER_KV, HEAD_DIM)
        kv = y[..., qd:]
    else:
        q = None
        kv = h @ w_qkv[:, qd:]
    k = kv[..., :kd].reshape(B, L, N_KV_HEADS, HEAD_DIM)
    v = kv[..., kd:].reshape(B, L, N_KV_HEADS, HEAD_DIM)
    return q, k, v


def windowed_attention(q, k, v, kc, vc, sink):
    B, L = q.shape[:2]
    nb = L // ATTN_BLOCK
    n_loc = 3 * ATTN_BLOCK
    n_ctx = kc.shape[1]
    pad = ((0, 0), (ATTN_BLOCK, ATTN_BLOCK), (0, 0), (0, 0))
    kp = jnp.pad(k, pad)
    vp = jnp.pad(v, pad)
    qb = jnp.moveaxis(q.reshape(B, nb, ATTN_BLOCK, N_KV_HEADS, Q_PER_KV, HEAD_DIM), 1, 0)
    sink_col = jnp.broadcast_to(sink[None, :, :, None, None], (B, N_KV_HEADS, Q_PER_KV, ATTN_BLOCK, 1))
    offs_q = jnp.arange(ATTN_BLOCK)
    offs_k = jnp.arange(n_loc)

    def block(args):
        qblk, n = args
        kblk = lax.dynamic_slice_in_dim(kp, n * ATTN_BLOCK, n_loc, axis=1)
        vblk = lax.dynamic_slice_in_dim(vp, n * ATTN_BLOCK, n_loc, axis=1)
        qpos = n * ATTN_BLOCK + offs_q
        kpos = (n - 1) * ATTN_BLOCK + offs_k
        valid = ((jnp.abs(kpos[None, :] - qpos[:, None]) <= WINDOW)
                 & (kpos >= 0)[None, :] & (kpos < L)[None, :])
        s_loc = jnp.einsum("bqkgd,bskd->bkgqs", qblk, kblk, preferred_element_type=jnp.float32) * ATTN_SCALE
        s_loc = jnp.where(valid, s_loc, -jnp.inf)
        s_ctx = jnp.einsum("bqkgd,bckd->bkgqc", qblk, kc, preferred_element_type=jnp.float32) * ATTN_SCALE
        p = jax.nn.softmax(jnp.concatenate([s_loc, s_ctx, sink_col], axis=-1), axis=-1).astype(v.dtype)
        o = (jnp.einsum("bkgqs,bskd->bqkgd", p[..., :n_loc], vblk)
             + jnp.einsum("bkgqc,bckd->bqkgd", p[..., n_loc:n_loc + n_ctx], vc))
        return o

    out = lax.map(block, (qb, jnp.arange(nb)))
    return jnp.moveaxis(out, 0, 1).reshape(B, L, N_HEADS * HEAD_DIM)


def context_attention(qc, kc, vc, sink):
    B, C = qc.shape[:2]
    s = jnp.einsum("bqkgd,bckd->bkgqc", qc, kc, preferred_element_type=jnp.float32) * ATTN_SCALE
    sink_col = jnp.broadcast_to(sink[None, :, :, None, None], (B, N_KV_HEADS, Q_PER_KV, C, 1))
    p = jax.nn.softmax(jnp.concatenate([s, sink_col], axis=-1), axis=-1).astype(vc.dtype)
    o = jnp.einsum("bkgqc,bckd->bqkgd", p[..., :C], vc)
    return o.reshape(B, C, N_HEADS * HEAD_DIM)


def attention_mixer(hc, hl, w_qkv, w_o, sink, cos, sin, want_ctx):
    ql, kl, vl = qkv_project(hl, w_qkv, True)
    ql = apply_axial_rope(ql, cos, sin)
    kl = apply_axial_rope(kl, cos, sin)
    qc, kc, vc = qkv_project(hc, w_qkv, want_ctx)
    sink_f = sink.astype(jnp.float32).reshape(N_KV_HEADS, Q_PER_KV)
    yl = windowed_attention(ql, kl, vl, kc, vc, sink_f) @ w_o
    yc = context_attention(qc, kc, vc, sink_f) @ w_o if want_ctx else None
    return yc, yl


def chunk_gmlp(h, w_in, b_in, ln_g, ln_b, w_s, b_s, w_out):
    B, L, _ = h.shape
    n = L // CHUNK
    z = jax.nn.gelu(h @ w_in + b_in)
    u, v = z[..., :GMLP_WIDTH], z[..., GMLP_WIDTH:]
    v = layer_norm(v, ln_g, ln_b).reshape(B, n, CHUNK, GMLP_GROUPS, GMLP_GROUP_DIM)
    s = jnp.einsum("gpq,bnqgc->bnpgc", w_s, v) + b_s[None, None, :, :, None]
    return (u * s.reshape(B, L, GMLP_WIDTH)) @ w_out


def short_gated_conv(h, w_in, w_conv, w_out):
    D = h.shape[-1]
    proj = h @ w_in
    gb, gc, z = proj[..., :D], proj[..., D:2 * D], proj[..., 2 * D:]
    z = gc * z
    zp = jnp.pad(z, ((0, 0), (1, 1), (0, 0)))
    zc = w_conv[0] * zp[:, :-2] + w_conv[1] * zp[:, 1:-1] + w_conv[2] * zp[:, 2:]
    return (gb * zc) @ w_out


def routed_moe(h, router_w, router_bias, w1, w3, w2):
    T, D = h.shape
    s = jax.nn.sigmoid(jnp.dot(h, router_w, preferred_element_type=jnp.float32))
    s_sel = s + router_bias.astype(jnp.float32)
    grp_score = lax.top_k(s_sel.reshape(T, N_EXPERT_GROUPS, EXPERTS_PER_GROUP), TOP_K)[0].sum(-1)
    g = jnp.argmax(grp_score, axis=-1)
    in_group = (jnp.arange(N_EXPERTS) // EXPERTS_PER_GROUP)[None, :] == g[:, None]
    _, idx = lax.top_k(jnp.where(in_group, s_sel, -jnp.inf), TOP_K)
    sc = jnp.take_along_axis(s, idx, axis=-1)
    gate = sc / jnp.sum(sc, axis=-1, keepdims=True)
    N = T * TOP_K
    e_flat = idx.reshape(N).astype(jnp.int32)
    tok = jnp.repeat(jnp.arange(T, dtype=jnp.int32), TOP_K)
    counts = jnp.bincount(e_flat, length=N_EXPERTS)
    padded = (counts + MOE_BLOCK - 1) // MOE_BLOCK * MOE_BLOCK
    pad_end = jnp.cumsum(padded)
    pad_start = pad_end - padded
    start = jnp.cumsum(counts) - counts
    order = jnp.argsort(e_flat, stable=True)
    e_sorted = e_flat[order]
    dest = pad_start[e_sorted] + jnp.arange(N, dtype=jnp.int32) - start[e_sorted]
    n_blocks = -(-N // MOE_BLOCK) + N_EXPERTS
    P = n_blocks * MOE_BLOCK
    row_tok = jnp.full((P,), T, jnp.int32).at[dest].set(tok[order])
    row_gate = jnp.zeros((P,), jnp.float32).at[dest].set(gate.reshape(N)[order])
    blk_expert = jnp.minimum(
        jnp.searchsorted(pad_end, jnp.arange(n_blocks, dtype=jnp.int32) * MOE_BLOCK, side="right"),
        N_EXPERTS - 1)
    h_pad = jnp.concatenate([h, jnp.zeros((1, D), h.dtype)], axis=0)
    xs = h_pad[row_tok].reshape(n_blocks, MOE_BLOCK, D)

    def expert_block(args):
        xb, e = args
        return (jax.nn.silu(xb @ w1[e]) * (xb @ w3[e])) @ w2[e]

    ys = lax.map(expert_block, (xs, blk_expert)).reshape(P, D)
    out = jax.ops.segment_sum(ys * row_gate[:, None].astype(ys.dtype), row_tok, num_segments=T + 1)
    return out[:T]


def setup_inputs(seed: int = 0) -> dict:
    key = jax.random.key(seed)
    keys = jax.random.split(key, 32)
    kgen = (keys[i] for i in range(32))
    D = D_MODEL

    def nrm(shape, scale):
        return jax.random.normal(next(kgen), shape, jnp.float32) * scale

    n_a = len(range(0, DEPTH, N_MIXERS))
    n_b = len(range(1, DEPTH, N_MIXERS))
    n_c = len(range(2, DEPTH, N_MIXERS))
    qkv_width = (N_HEADS + 2 * N_KV_HEADS) * HEAD_DIM
    return {
        "x": nrm((BATCH, SEQ, D), 1.0),
        "c": nrm((BATCH, D), 1.0),
        "ctx": nrm((BATCH, CTX_LEN, D), 1.0),
        "c_ctx": nrm((D,), 1.0),
        "w_mod": nrm((DEPTH, D, 6 * D), 0.5 * D ** -0.5),
        "b_mod": nrm((DEPTH, 6 * D), 0.02),
        "ln1_g": 1.0 + nrm((DEPTH, D), 0.02),
        "ln1_b": nrm((DEPTH, D), 0.02),
        "ln2_g": 1.0 + nrm((DEPTH, D), 0.02),
        "ln2_b": nrm((DEPTH, D), 0.02),
        "router_w": nrm((D, N_EXPERTS), D ** -0.5),
        "router_bias": nrm((N_EXPERTS,), 0.01),
        "moe_w1": nrm((DEPTH, N_EXPERTS, D, D_EXPERT), D ** -0.5),
        "moe_w3": nrm((DEPTH, N_EXPERTS, D, D_EXPERT), D ** -0.5),
        "moe_w2": nrm((DEPTH, N_EXPERTS, D_EXPERT, D), BETA * D_EXPERT ** -0.5),
        "a_w_qkv": nrm((n_a, D, qkv_width), D ** -0.5),
        "a_w_o": nrm((n_a, N_HEADS * HEAD_DIM, D), BETA * (N_HEADS * HEAD_DIM) ** -0.5),
        "a_sink": nrm((n_a, N_HEADS), 0.5),
        "b_w_in": nrm((n_b, D, 2 * GMLP_WIDTH), D ** -0.5),
        "b_b_in": nrm((n_b, 2 * GMLP_WIDTH), 0.02),
        "b_ln_g": 1.0 + nrm((n_b, GMLP_WIDTH), 0.02),
        "b_ln_b": nrm((n_b, GMLP_WIDTH), 0.02),
        "b_w_s": nrm((n_b, GMLP_GROUPS, CHUNK, CHUNK), 0.5 * CHUNK ** -0.5),
        "b_b_s": 1.0 + nrm((n_b, CHUNK, GMLP_GROUPS), 0.02),
        "b_w_out": nrm((n_b, GMLP_WIDTH, D), BETA * GMLP_WIDTH ** -0.5),
        "c_w_in": nrm((n_c, D, 3 * D), D ** -0.5),
        "c_w_conv": nrm((n_c, CONV_WIDTH, D), CONV_WIDTH ** -0.5),
        "c_w_out": nrm((n_c, D, D), BETA * D ** -0.5),
    }


def reference(x, c, ctx, c_ctx, w_mod, b_mod, ln1_g, ln1_b, ln2_g, ln2_b,
              router_w, router_bias, moe_w1, moe_w3, moe_w2,
              a_w_qkv, a_w_o, a_sink,
              b_w_in, b_b_in, b_ln_g, b_ln_b, b_w_s, b_b_s, b_w_out,
              c_w_in, c_w_conv, c_w_out):
    B, L, D = x.shape
    C = ctx.shape[1]
    cos, sin = axial_rope_tables(L, x.dtype)
    silu_c = jax.nn.silu(c)
    silu_cc = jax.nn.silu(c_ctx)
    for i in range(DEPTH):
        kind, j = i % N_MIXERS, i // N_MIXERS
        want_ctx = i < DEPTH - 1
        mod_l = (silu_c @ w_mod[i] + b_mod[i])[:, None, :]
        mod_c = (silu_cc @ w_mod[i] + b_mod[i])[None, None, :]
        sh_a, sc_a, g_a, sh_f, sc_f, g_f = jnp.split(mod_l, 6, axis=-1)
        csh_a, csc_a, cg_a, csh_f, csc_f, cg_f = jnp.split(mod_c, 6, axis=-1)
        hl = modulate(x, sh_a, sc_a)
        hc = modulate(ctx, csh_a, csc_a)
        if kind == 0:
            yc, yl = attention_mixer(hc, hl, a_w_qkv[j], a_w_o[j], a_sink[j], cos, sin, want_ctx)
        elif kind == 1:
            gm = (b_w_in[j], b_b_in[j], b_ln_g[j], b_ln_b[j], b_w_s[j], b_b_s[j], b_w_out[j])
            yl = chunk_gmlp(hl, *gm)
            yc = chunk_gmlp(hc, *gm) if want_ctx else None
        else:
            sc_w = (c_w_in[j], c_w_conv[j], c_w_out[j])
            yl = short_gated_conv(hl, *sc_w)
            yc = short_gated_conv(hc, *sc_w) if want_ctx else None
        x = layer_norm(ALPHA * x + g_a * yl, ln1_g[i], ln1_b[i])
        if want_ctx:
            ctx = layer_norm(ALPHA * ctx + cg_a * yc, ln1_g[i], ln1_b[i])
        hl = modulate(x, sh_f, sc_f)
        if want_ctx:
            hc = modulate(ctx, csh_f, csc_f)
            tokens = jnp.concatenate([hc.reshape(-1, D), hl.reshape(-1, D)], axis=0)
        else:
            tokens = hl.reshape(-1, D)
        y = routed_moe(tokens, router_w, router_bias, moe_w1[i], moe_w3[i], moe_w2[i])
        x = layer_norm(ALPHA * x + g_f * y[-B * L:].reshape(B, L, D), ln2_g[i], ln2_b[i])
        if want_ctx:
            ctx = layer_norm(ALPHA * ctx + cg_f * y[:B * C].reshape(B, C, D), ln2_g[i], ln2_b[i])
    return x
```

```cpp
#include <hip/hip_runtime.h>
#include <cstdio>
#include <cstdint>

#define LAS __attribute__((address_space(3)))
typedef unsigned short bf16_t;
typedef short bf16x8 __attribute__((ext_vector_type(8)));
typedef float f32x4 __attribute__((ext_vector_type(4)));
typedef float f32x16 __attribute__((ext_vector_type(16)));
typedef unsigned u32x4 __attribute__((ext_vector_type(4)));
typedef unsigned u32x2 __attribute__((ext_vector_type(2)));

constexpr int D = 1024, L = 16384, C = 256, T = L + C, DEPTH = 4;
constexpr int NEXP = 16, DEXP = 512;
constexpr int QKVW = 1536;
constexpr float ALPHA = 1.681792830507429f;
constexpr float LN_EPS = 1e-5f;
constexpr int NTHREADS = 512;
constexpr int LDS_BYTES = 147456;
constexpr int PMAX = 37632;

constexpr size_t al256(size_t x) { return (x + 255) & ~(size_t)255; }
constexpr size_t WS_CTL   = 0;
constexpr size_t CTL_BYTES = 32768;
constexpr size_t CW_CNT   = 4096;
constexpr size_t WS_MODP  = WS_CTL + CTL_BYTES;
constexpr size_t WS_ROPE  = WS_MODP + al256((size_t)4 * 8 * 2 * 6144 * 4);
constexpr size_t WS_WQKV  = WS_ROPE + (size_t)L * 64 * 4;
constexpr size_t WS_WO    = WS_WQKV + (size_t)2 * 1536 * 1024 * 2;
constexpr size_t WS_WBIN  = WS_WO + (size_t)2 * 1024 * 1024 * 2;
constexpr size_t WS_WBS   = WS_WBIN + (size_t)2048 * 1024 * 2;
constexpr size_t WS_WBOUT = WS_WBS + (size_t)8 * 128 * 128 * 2;
constexpr size_t WS_WCIN  = WS_WBOUT + (size_t)1024 * 1024 * 2;
constexpr size_t WS_WCOUT = WS_WCIN + (size_t)3072 * 1024 * 2;
constexpr size_t WS_W13   = WS_WCOUT + (size_t)1024 * 1024 * 2;
constexpr size_t WS_W2    = WS_W13 + (size_t)64 * 1024 * 1024 * 2;
constexpr size_t WS_X     = WS_W2 + (size_t)64 * 1024 * 512 * 2;
constexpr size_t WS_H     = WS_X + (size_t)T * 1024 * 4;
constexpr size_t WS_Y1    = WS_H + (size_t)T * 1024 * 2;
constexpr size_t WS_MID   = WS_Y1 + (size_t)T * 3072 * 2;
constexpr size_t WS_YL    = WS_MID + (size_t)T * 1024 * 2;
constexpr size_t WS_TOK   = WS_YL + (size_t)T * 1024 * 2 + 4 * 1024 * 1024;
constexpr size_t WS_ASG   = WS_TOK + (size_t)16 * T * 4;
constexpr size_t WS_END   = WS_ASG + (size_t)T * 16;
static_assert((size_t)PMAX * 1024 * 2 <= (size_t)T * 3072 * 2, "YS alias");
static_assert((size_t)PMAX * 512 * 2 <= (size_t)2 * T * 1024 * 2 + 4 * 1024 * 1024, "HID alias");

__device__ __forceinline__ unsigned cvt_pk_bf16(float lo, float hi) { unsigned r; asm volatile("v_cvt_pk_bf16_f32 %0, %1, %2" : "=v"(r) : "v"(lo), "v"(hi)); return r; }
__device__ __forceinline__ float bf2f(unsigned short b) { return __uint_as_float((unsigned)b << 16); }
__device__ __forceinline__ float bflo(unsigned w) { return __uint_as_float(w << 16); }
__device__ __forceinline__ float bfhi(unsigned w) { return __uint_as_float(w & 0xffff0000u); }
__device__ __forceinline__ float wave_sum(float v) {
#pragma unroll
    for (int o = 32; o > 0; o >>= 1) v += __shfl_xor(v, o);
    return v;
}
__device__ __forceinline__ float silu_f(float x) { return x / (1.0f + __expf(-x)); }
__device__ __forceinline__ float gelu_tanh_f(float x) {
    const float u = 0.7978845608028654f * (x + 0.044715f * x * x * x);
    const float e = __expf(2.0f * u);
    const float t = 1.0f - 2.0f / (e + 1.0f);
    return 0.5f * x * (1.0f + t);
}

#define XB_TMO      128
#define XB_XCNT(j)  (256  + 64 * (j))
#define XB_XSUB(j)  (1280 + 64 * (j))
#define XB_XGEN(j)  (2304 + 64 * (j))
#define XB_TOP      3328
#define XB_TOPGEN   3392
#define XCD_BAR_WORDS 3456
#define XB_SPIN_CAP (1u << 18)

__device__ __forceinline__ unsigned xb_ld(unsigned* p)              { return __hip_atomic_load(p, __ATOMIC_RELAXED, __HIP_MEMORY_SCOPE_AGENT); }
__device__ __forceinline__ unsigned xb_add(unsigned* p, unsigned v) { return __hip_atomic_fetch_add(p, v, __ATOMIC_RELAXED, __HIP_MEMORY_SCOPE_AGENT); }
__device__ __forceinline__ unsigned xb_xcc_id() { return (unsigned)__builtin_amdgcn_s_getreg((3 << 11) | 20) & 0xFu; }
#define XB_SPIN(cond, bar) do { unsigned _sp = 0; while (cond) { __builtin_amdgcn_s_sleep(1); \
    if ((++_sp & 255u) == 0u) { if (xb_ld(&(bar)[XB_TMO])) break; if (_sp > XB_SPIN_CAP) { atomicAdd(&(bar)[XB_TMO], 1u); break; } } } } while (0)

struct XcdBarrier { unsigned* bar; unsigned x; volatile LAS unsigned* st; };

__device__ __forceinline__ XcdBarrier xcd_barrier_post(unsigned* bar, volatile LAS unsigned* st) {
    XcdBarrier b; b.bar = bar; b.x = xb_xcc_id(); b.st = st;
    if (threadIdx.x == 0) (void)xb_add(&bar[XB_XCNT(b.x)], 1u);
    return b;
}
__device__ __forceinline__ void xcd_barrier_complete(unsigned* bar, unsigned x, unsigned& nloc, unsigned& nx) {
    const unsigned G = gridDim.x * gridDim.y * gridDim.z;
    unsigned sum, cnt, mine, sp = 0u;
    for (;;) {
        sum = 0u; cnt = 0u; mine = 0u;
#pragma unroll
        for (unsigned j = 0; j < 16; ++j) { const unsigned c = xb_ld(&bar[XB_XCNT(j)]); sum += c; cnt += (c > 0u) ? 1u : 0u; mine = (j == x) ? c : mine; }
        if (sum == G) break;
        __builtin_amdgcn_s_sleep(1);
        if ((++sp & 255u) == 0u) { if (xb_ld(&bar[XB_TMO])) break; if (sp > XB_SPIN_CAP) { atomicAdd(&bar[XB_TMO], 1u); break; } }
    }
    nloc = mine > 0u ? mine : 1u; nx = cnt > 0u ? cnt : 1u;
}
__device__ __forceinline__ void xcd_barrier(const XcdBarrier& b) {
    asm volatile("s_waitcnt vmcnt(0)" ::: "memory");
    __syncthreads();
    if (threadIdx.x == 0) {
        unsigned* bar = b.bar;
        __builtin_amdgcn_s_waitcnt(0);
        unsigned nloc = b.st[0], nx = b.st[1];
        if (nloc == 0u) { xcd_barrier_complete(bar, b.x, nloc, nx); b.st[0] = nloc; b.st[1] = nx; }
        const unsigned old = xb_add(&bar[XB_XSUB(b.x)], 1u);
        const unsigned gen = old / nloc;
        if (old + 1u == (gen + 1u) * nloc) {
            __builtin_amdgcn_fence(__ATOMIC_RELEASE, "agent");
            asm volatile("s_waitcnt vmcnt(0)" ::: "memory");
            const unsigned og = xb_add(&bar[XB_TOP], 1u);
            const unsigned tg = og / nx;
            if (og + 1u == (tg + 1u) * nx) xb_add(&bar[XB_TOPGEN], 1u);
            else XB_SPIN(xb_ld(&bar[XB_TOPGEN]) == tg, bar);
            __builtin_amdgcn_fence(__ATOMIC_ACQUIRE, "agent");
            xb_add(&bar[XB_XGEN(b.x)], 1u);
            asm volatile("s_waitcnt vmcnt(0)" ::: "memory");
        } else {
            XB_SPIN(xb_ld(&bar[XB_XGEN(b.x)]) == gen, bar);
            __builtin_amdgcn_fence(__ATOMIC_ACQUIRE, "agent");
            asm volatile("s_waitcnt vmcnt(0)" ::: "memory");
        }
    }
    __syncthreads();
}

struct Params {
    const float* in[28];
    float* out;
    unsigned char* ws;
};
enum { I_X = 0, I_C, I_CTX, I_CCTX, I_WMOD, I_BMOD, I_LN1G, I_LN1B, I_LN2G, I_LN2B, I_RW, I_RB, I_W1, I_W3, I_W2,
       I_AQKV, I_AO, I_ASINK, I_BWIN, I_BBIN, I_BLNG, I_BLNB, I_BWS, I_BBS, I_BWOUT, I_CWIN, I_CWCONV, I_CWOUT };

constexpr int GT_LDT = 40;
template <class ARow, class Epi>
__device__ __forceinline__ void gemm_tile_s(LAS unsigned char* lds, const ARow& arow, const bf16_t* Bt, const int K, const Epi& epi) {
    const int tid = threadIdx.x, wid = tid >> 6, lane = tid & 63, wr = wid >> 1, wc = wid & 1, fr = lane & 15, fq = lane >> 4;
    LAS bf16_t* sA = (LAS bf16_t*)lds;
    LAS bf16_t* sB = sA + 256 * GT_LDT;
    const bf16_t* ap0 = arow(tid >> 2) + (tid & 3) * 8;
    const bf16_t* ap1 = arow((tid >> 2) + 128) + (tid & 3) * 8;
    const bf16_t* bp = Bt + (size_t)(tid >> 2) * K + (tid & 3) * 8;
    f32x4 acc[4][4];
#pragma unroll
    for (int m = 0; m < 4; ++m)
#pragma unroll
        for (int n = 0; n < 4; ++n) acc[m][n] = (f32x4){0.f, 0.f, 0.f, 0.f};
    u32x4 ra0 = *(const u32x4*)ap0, ra1 = *(const u32x4*)ap1, rb = *(const u32x4*)bp;
    for (int k0 = 0; k0 < K; k0 += 32) {
        __syncthreads();
        *(LAS u32x4*)(sA + (tid >> 2) * GT_LDT + (tid & 3) * 8) = ra0;
        *(LAS u32x4*)(sA + ((tid >> 2) + 128) * GT_LDT + (tid & 3) * 8) = ra1;
        if (tid < 512) *(LAS u32x4*)(sB + (tid >> 2) * GT_LDT + (tid & 3) * 8) = rb;
        __syncthreads();
        if (k0 + 32 < K) { ra0 = *(const u32x4*)(ap0 + k0 + 32); ra1 = *(const u32x4*)(ap1 + k0 + 32); rb = *(const u32x4*)(bp + k0 + 32); }
        bf16x8 af[4], bfr[4];
#pragma unroll
        for (int m = 0; m < 4; ++m) af[m] = *(const LAS bf16x8*)(sA + (wr * 64 + m * 16 + fr) * GT_LDT + fq * 8);
#pragma unroll
        for (int n = 0; n < 4; ++n) bfr[n] = *(const LAS bf16x8*)(sB + (wc * 64 + n * 16 + fr) * GT_LDT + fq * 8);
#pragma unroll
        for (int m = 0; m < 4; ++m)
#pragma unroll
            for (int n = 0; n < 4; ++n) acc[m][n] = __builtin_amdgcn_mfma_f32_16x16x32_bf16(bfr[n], af[m], acc[m][n], 0, 0, 0);
    }
#pragma unroll
    for (int m = 0; m < 4; ++m)
#pragma unroll
        for (int n = 0; n < 4; ++n) epi(wr * 64 + m * 16 + fr, wc * 64 + n * 16 + fq * 4, acc[m][n]);
}

struct ARowDirect { const bf16_t* base; int ld; __device__ __forceinline__ const bf16_t* operator()(int r) const { return base + (size_t)r * ld; } };
struct ARowGather { const bf16_t* H; const int* toks; int nvalid; __device__ __forceinline__ const bf16_t* operator()(int r) const { const int t = (r < nvalid) ? toks[r] : 0; return H + (size_t)t * 1024; } };

__device__ __forceinline__ void store_bf16x4(bf16_t* p, f32x4 v) { u32x2 w; w.x = cvt_pk_bf16(v[0], v[1]); w.y = cvt_pk_bf16(v[2], v[3]); *(u32x2*)p = w; }

struct EpiPlain { bf16_t* O; int ldo; __device__ __forceinline__ void operator()(int r, int c, f32x4 v) const { store_bf16x4(O + (size_t)r * ldo + c, v); } };
struct EpiGelu { bf16_t* O; int ldo; const float* bias; __device__ __forceinline__ void operator()(int r, int c, f32x4 v) const {
    const f32x4 b = *(const f32x4*)(bias + c);
    f32x4 o; o[0] = gelu_tanh_f(v[0] + b[0]); o[1] = gelu_tanh_f(v[1] + b[1]); o[2] = gelu_tanh_f(v[2] + b[2]); o[3] = gelu_tanh_f(v[3] + b[3]);
    store_bf16x4(O + (size_t)r * ldo + c, o); } };
struct EpiQkv { bf16_t* O; const float* rope; int row0; int col0; __device__ __forceinline__ void operator()(int r, int c, f32x4 v) const {
    const int row = row0 + r, col = col0 + c;
    if (col < 1280 && row < L) {
        const int pi = (col & 63) >> 1;
        const float* tp = rope + (size_t)row * 64 + pi;
        const float c0 = tp[0], c1 = tp[1], s0 = tp[32], s1 = tp[33];
        f32x4 o; o[0] = v[0] * c0 - v[1] * s0; o[1] = v[1] * c0 + v[0] * s0; o[2] = v[2] * c1 - v[3] * s1; o[3] = v[3] * c1 + v[2] * s1; v = o;
    }
    store_bf16x4(O + (size_t)row * QKVW + col, v); } };
struct EpiSwiglu { bf16_t* O; __device__ __forceinline__ void operator()(int r, int c, f32x4 v) const {
    const float h0 = silu_f(v[0]) * v[1], h1 = silu_f(v[2]) * v[3];
    *(unsigned*)(O + (size_t)r * DEXP + (c >> 1)) = cvt_pk_bf16(h0, h1); } };

__device__ __forceinline__ void load_mod(LAS float* dst, const float* modp, const float* bmod, int layer, int chunk, int vec) {
    for (int j = threadIdx.x; j < 1024; j += NTHREADS) {
        float s = bmod[layer * 6144 + chunk * 1024 + j];
#pragma unroll
        for (int ks = 0; ks < 8; ++ks) s += modp[(((size_t)layer * 8 + ks) * 2 + vec) * 6144 + chunk * 1024 + j];
        dst[j] = s;
    }
}

__device__ __forceinline__ void cvt_tile(LAS unsigned char* lds, const float* src, const float* src2, int ldsrc, int mode, bf16_t* dst, int ldd, int n0, int k0) {
    LAS float* tf = (LAS float*)lds;
    const int tid = threadIdx.x;
    __syncthreads();
    {
        const int nl = tid & 63, kq = tid >> 6, n = n0 + nl;
        const float* s = src; int col = n;
        if (mode == 1) { if (n < 1280) { const int jn = n & 63, blk = jn >> 5, i = jn & 31; col = (n & ~63) + blk * 32 + (i & 1) * 16 + (i >> 1); } }
        else if (mode == 2) { s = (n & 1) ? src2 : src; col = n >> 1; }
#pragma unroll
        for (int j = 0; j < 8; ++j) { const int kk = kq + 8 * j; tf[kk * 65 + nl] = s[(size_t)(k0 + kk) * ldsrc + col]; }
    }
    __syncthreads();
    const int n = tid >> 3, kb = (tid & 7) * 8;
    float v[8];
#pragma unroll
    for (int j = 0; j < 8; ++j) v[j] = tf[(kb + j) * 65 + n];
    u32x4 w; w.x = cvt_pk_bf16(v[0], v[1]); w.y = cvt_pk_bf16(v[2], v[3]); w.z = cvt_pk_bf16(v[4], v[5]); w.w = cvt_pk_bf16(v[6], v[7]);
    *(u32x4*)(dst + (size_t)(n0 + n) * ldd + k0 + kb) = w;
}

struct Ctx {
    Params p; LAS unsigned char* lds; int bid, nb, tid, wid, lane;
    unsigned char* ws;
    float* modp; float* rope; bf16_t *wqkv, *wo, *wbin, *wbs, *wbout, *wcin, *wcout, *w13, *w2;
    float* X; bf16_t *H, *Y1, *MID, *YL, *HID, *YS; int* tok; unsigned* asg; unsigned* cnt;
};

__device__ __forceinline__ void phase_prep(const Ctx& c) {
    const Params& p = c.p;
    constexpr int T_QKV = 24 * 16, T_O = 16 * 16, T_BIN = 32 * 16, T_BOUT = 256, T_CIN = 48 * 16, T_COUT = 256, T_W13 = 256, T_W2 = 16 * 8;
    constexpr int S0 = 0, S1 = S0 + 2 * T_QKV, S2 = S1 + 2 * T_O, S3 = S2 + T_BIN, S4 = S3 + T_BOUT, S5 = S4 + T_CIN, S6 = S5 + T_COUT, S7 = S6 + 64 * T_W13, S8 = S7 + 64 * T_W2;
    for (int u = c.bid; u < S8; u += c.nb) {
        if (u < S1) { const int j = u / T_QKV, t = u % T_QKV; cvt_tile(c.lds, p.in[I_AQKV] + (size_t)j * 1024 * 1536, nullptr, 1536, 1, c.wqkv + (size_t)j * 1536 * 1024, 1024, (t / 16) * 64, (t % 16) * 64); }
        else if (u < S2) { const int v = u - S1, j = v / T_O, t = v % T_O; cvt_tile(c.lds, p.in[I_AO] + (size_t)j * 1024 * 1024, nullptr, 1024, 0, c.wo + (size_t)j * 1024 * 1024, 1024, (t / 16) * 64, (t % 16) * 64); }
        else if (u < S3) { const int t = u - S2; cvt_tile(c.lds, p.in[I_BWIN], nullptr, 2048, 0, c.wbin, 1024, (t / 16) * 64, (t % 16) * 64); }
        else if (u < S4) { const int t = u - S3; cvt_tile(c.lds, p.in[I_BWOUT], nullptr, 1024, 0, c.wbout, 1024, (t / 16) * 64, (t % 16) * 64); }
        else if (u < S5) { const int t = u - S4; cvt_tile(c.lds, p.in[I_CWIN], nullptr, 3072, 0, c.wcin, 1024, (t / 16) * 64, (t % 16) * 64); }
        else if (u < S6) { const int t = u - S5; cvt_tile(c.lds, p.in[I_CWOUT], nullptr, 1024, 0, c.wcout, 1024, (t / 16) * 64, (t % 16) * 64); }
        else if (u < S7) { const int v = u - S6, le = v / T_W13, t = v % T_W13;
            cvt_tile(c.lds, p.in[I_W1] + (size_t)le * 1024 * 512, p.in[I_W3] + (size_t)le * 1024 * 512, 512, 2, c.w13 + (size_t)le * 1024 * 1024, 1024, (t / 16) * 64, (t % 16) * 64); }
        else { const int v = u - S7, le = v / T_W2, t = v % T_W2;
            cvt_tile(c.lds, p.in[I_W2] + (size_t)le * 512 * 1024, nullptr, 1024, 0, c.w2 + (size_t)le * 1024 * 512, 512, (t / 8) * 64, (t % 8) * 64); }
    }
    for (int i = c.bid * NTHREADS + c.tid; i < 8 * 128 * 128 / 2; i += c.nb * NTHREADS) {
        const float a = p.in[I_BWS][2 * i], b = p.in[I_BWS][2 * i + 1];
        ((unsigned*)c.wbs)[i] = cvt_pk_bf16(a, b);
    }
    __syncthreads();
    LAS float* sl = (LAS float*)c.lds;
    for (int j = c.tid; j < 1024; j += NTHREADS) { sl[j] = silu_f(p.in[I_C][j]); sl[1024 + j] = silu_f(p.in[I_CCTX][j]); }
    __syncthreads();
    for (int u = c.bid; u < 4 * 12 * 8; u += c.nb) {
        const int layer = u / 96, r = u % 96, cc = r / 8, ks = r % 8;
        const int col = cc * 512 + c.tid;
        const float* w = p.in[I_WMOD] + (size_t)layer * 1024 * 6144 + (size_t)(ks * 128) * 6144 + col;
        float a0 = 0.f, a1 = 0.f;
#pragma unroll 8
        for (int k = 0; k < 128; ++k) { const float wv = w[(size_t)k * 6144]; a0 += sl[ks * 128 + k] * wv; a1 += sl[1024 + ks * 128 + k] * wv; }
        c.modp[(((size_t)layer * 8 + ks) * 2 + 0) * 6144 + col] = a0;
        c.modp[(((size_t)layer * 8 + ks) * 2 + 1) * 6144 + col] = a1;
    }
    for (int i = c.bid * NTHREADS + c.tid; i < L * 32; i += c.nb * NTHREADS) {
        const int pos = i >> 5, m = i & 31;
        const float freq = (float)pow(10000.0, -(double)(m & 15) / 16.0);
        const float ang = (float)((m < 16) ? (pos >> 6) : (pos & 63)) * freq;
        c.rope[(size_t)pos * 64 + m] = (float)cos((double)ang);
        c.rope[(size_t)pos * 64 + 32 + m] = (float)sin((double)ang);
    }
}

__device__ __forceinline__ void phase_mod0(const Ctx& c) {
    LAS float* mv = (LAS float*)c.lds;
    __syncthreads();
    load_mod(mv, c.modp, c.p.in[I_BMOD], 0, 0, 0); load_mod(mv + 1024, c.modp, c.p.in[I_BMOD], 0, 1, 0);
    load_mod(mv + 2048, c.modp, c.p.in[I_BMOD], 0, 0, 1); load_mod(mv + 3072, c.modp, c.p.in[I_BMOD], 0, 1, 1);
    __syncthreads();
    const int rpb = T / 256;
    for (int i = c.wid; i < rpb; i += 8) {
        const int row = c.bid * rpb + i; const bool ic = row >= L;
        const float* xr = ic ? c.p.in[I_CTX] + (size_t)(row - L) * 1024 : c.p.in[I_X] + (size_t)row * 1024;
        LAS float* sh = mv + (ic ? 2048 : 0); LAS float* sc = sh + 1024;
#pragma unroll
        for (int j = 0; j < 4; ++j) {
            const int col = 4 * c.lane + 256 * j;
            const f32x4 x = *(const f32x4*)(xr + col);
            f32x4 h;
#pragma unroll
            for (int e = 0; e < 4; ++e) h[e] = x[e] * (1.0f + sc[col + e]) + sh[col + e];
            store_bf16x4(c.H + (size_t)row * 1024 + col, h);
        }
    }
}

template <int KIND>
__device__ __forceinline__ void phase_g1(const Ctx& c, int j) {
    constexpr int N = KIND == 0 ? 1536 : (KIND == 1 ? 2048 : 3072);
    constexpr int nN = N / 128, nM = T / 256;
    const bf16_t* W = KIND == 0 ? c.wqkv + (size_t)j * 1536 * 1024 : (KIND == 1 ? c.wbin : c.wcin);
    for (int u = c.bid; u < nM * nN; u += c.nb) {
        const int pm = u / nN, pn = u % nN;
        ARowDirect ar{c.H + (size_t)pm * 256 * 1024, 1024};
        const bf16_t* Bt = W + (size_t)pn * 128 * 1024;
        if constexpr (KIND == 0) { EpiQkv e{c.Y1, c.rope, pm * 256, pn * 128}; gemm_tile_s(c.lds, ar, Bt, 1024, e); }
        else if constexpr (KIND == 1) { EpiGelu e{c.Y1 + (size_t)pm * 256 * N + pn * 128, N, c.p.in[I_BBIN] + pn * 128}; gemm_tile_s(c.lds, ar, Bt, 1024, e); }
        else { EpiPlain e{c.Y1 + (size_t)pm * 256 * N + pn * 128, N}; gemm_tile_s(c.lds, ar, Bt, 1024, e); }
    }
}
__device__ __forceinline__ void phase_g2(const Ctx& c, const bf16_t* W, int nrows) {
    const int nM = nrows / 256;
    for (int u = c.bid; u < nM * 8; u += c.nb) {
        const int pm = u / 8, pn = u % 8;
        ARowDirect ar{c.MID + (size_t)pm * 256 * 1024, 1024};
        EpiPlain e{c.YL + (size_t)pm * 256 * 1024 + pn * 128, 1024};
        gemm_tile_s(c.lds, ar, W + (size_t)pn * 128 * 1024, 1024, e);
    }
}

__device__ __forceinline__ void phase_attn(const Ctx& c, const float* sink, bool ctxq) {
    constexpr int KS = 72, VS = 68;
    LAS bf16_t* sK = (LAS bf16_t*)c.lds;
    LAS bf16_t* sVT = sK + 64 * KS;
    const int g = c.wid >> 1, qh = c.wid & 1, ql = c.lane & 31, hi = c.lane >> 5;
    const int nqb = 256 + (ctxq ? 4 : 0);
    const float SC2 = 0.125f * 1.4426950408889634f;
    const int lkey = c.tid >> 3, lpc = c.tid & 7;
    for (int u = c.bid; u < nqb * 4; u += c.nb) {
        const int kvh = u / nqb, qb = u % nqb;
        const bool isctx = qb >= 256;
        const int qrow0 = isctx ? L + (qb - 256) * 64 : qb * 64;
        const int myq = qrow0 + qh * 32 + ql;
        const int head = kvh * 4 + g;
        bf16x8 qf[4];
#pragma unroll
        for (int s = 0; s < 4; ++s) qf[s] = *(const bf16x8*)(c.Y1 + (size_t)myq * QKVW + head * 64 + 16 * s + 8 * hi);
        float m_run = sink[head] * 1.4426950408889634f, l_run = (hi == 0) ? 1.0f : 0.0f;
        f32x16 oacc[2];
#pragma unroll
        for (int r = 0; r < 16; ++r) { oacc[0][r] = 0.f; oacc[1][r] = 0.f; }
        for (int ti = 0; ti < 9; ++ti) {
            int k0;
            if (ti < 5) { k0 = qrow0 - 128 + 64 * ti; if (isctx || k0 < 0 || k0 >= L) continue; }
            else k0 = L + 64 * (ti - 5);
            const u32x4 kr = *(const u32x4*)(c.Y1 + (size_t)(k0 + lkey) * QKVW + 1024 + kvh * 64 + lpc * 8);
            const u32x4 vr = *(const u32x4*)(c.Y1 + (size_t)(k0 + lkey) * QKVW + 1280 + kvh * 64 + lpc * 8);
            __syncthreads();
            *(LAS u32x4*)(sK + lkey * KS + lpc * 8) = kr;
            sVT[(lpc * 8 + 0) * VS + lkey] = (bf16_t)(vr.x & 0xffff); sVT[(lpc * 8 + 1) * VS + lkey] = (bf16_t)(vr.x >> 16);
            sVT[(lpc * 8 + 2) * VS + lkey] = (bf16_t)(vr.y & 0xffff); sVT[(lpc * 8 + 3) * VS + lkey] = (bf16_t)(vr.y >> 16);
            sVT[(lpc * 8 + 4) * VS + lkey] = (bf16_t)(vr.z & 0xffff); sVT[(lpc * 8 + 5) * VS + lkey] = (bf16_t)(vr.z >> 16);
            sVT[(lpc * 8 + 6) * VS + lkey] = (bf16_t)(vr.w & 0xffff); sVT[(lpc * 8 + 7) * VS + lkey] = (bf16_t)(vr.w >> 16);
            __syncthreads();
            f32x16 sacc[2];
#pragma unroll
            for (int r = 0; r < 16; ++r) { sacc[0][r] = 0.f; sacc[1][r] = 0.f; }
#pragma unroll
            for (int ks = 0; ks < 2; ++ks)
#pragma unroll
                for (int s = 0; s < 4; ++s) {
                    const bf16x8 kf = *(const LAS bf16x8*)(sK + (32 * ks + ql) * KS + 16 * s + 8 * hi);
                    sacc[ks] = __builtin_amdgcn_mfma_f32_32x32x16_bf16(kf, qf[s], sacc[ks], 0, 0, 0);
                }
            float mx = -INFINITY;
#pragma unroll
            for (int ks = 0; ks < 2; ++ks)
#pragma unroll
                for (int r = 0; r < 16; ++r) {
                    float v = sacc[ks][r] * SC2;
                    if (ti == 0 || ti == 4) {
                        const int kpos = k0 + 32 * ks + (r & 3) + 8 * (r >> 2) + 4 * hi;
                        const int dlt = kpos - myq;
                        if (dlt < -128 || dlt > 128) v = -INFINITY;
                    }
                    sacc[ks][r] = v; mx = fmaxf(mx, v);
                }
            mx = fmaxf(mx, __shfl_xor(mx, 32));
            const float m_new = fmaxf(m_run, mx);
            const float alpha = exp2f(m_run - m_new);
            m_run = m_new; l_run *= alpha;
#pragma unroll
            for (int r = 0; r < 16; ++r) { oacc[0][r] *= alpha; oacc[1][r] *= alpha; }
            float ls = 0.f;
            bf16x8 pb[2][2];
#pragma unroll
            for (int ks = 0; ks < 2; ++ks)
#pragma unroll
                for (int s2 = 0; s2 < 2; ++s2) {
                    float e[8];
#pragma unroll
                    for (int jj = 0; jj < 8; ++jj) { e[jj] = exp2f(sacc[ks][8 * s2 + jj] - m_new); ls += e[jj]; }
                    u32x4 w; w.x = cvt_pk_bf16(e[0], e[1]); w.y = cvt_pk_bf16(e[2], e[3]); w.z = cvt_pk_bf16(e[4], e[5]); w.w = cvt_pk_bf16(e[6], e[7]);
                    pb[ks][s2] = __builtin_bit_cast(bf16x8, w);
                }
            l_run += ls;
#pragma unroll
            for (int dt = 0; dt < 2; ++dt)
#pragma unroll
                for (int ks = 0; ks < 2; ++ks)
#pragma unroll
                    for (int s2 = 0; s2 < 2; ++s2) {
                        const int kb = 32 * ks + 16 * s2;
                        const u32x2 lo = *(const LAS u32x2*)(sVT + (32 * dt + ql) * VS + kb + 4 * hi);
                        const u32x2 hh = *(const LAS u32x2*)(sVT + (32 * dt + ql) * VS + kb + 8 + 4 * hi);
                        u32x4 w; w.x = lo.x; w.y = lo.y; w.z = hh.x; w.w = hh.y;
                        oacc[dt] = __builtin_amdgcn_mfma_f32_32x32x16_bf16(__builtin_bit_cast(bf16x8, w), pb[ks][s2], oacc[dt], 0, 0, 0);
                    }
        }
        const float lt = l_run + __shfl_xor(l_run, 32);
        const float inv = 1.0f / lt;
#pragma unroll
        for (int dt = 0; dt < 2; ++dt)
#pragma unroll
            for (int rq = 0; rq < 4; ++rq) {
                f32x4 o; o[0] = oacc[dt][4 * rq] * inv; o[1] = oacc[dt][4 * rq + 1] * inv; o[2] = oacc[dt][4 * rq + 2] * inv; o[3] = oacc[dt][4 * rq + 3] * inv;
                store_bf16x4(c.MID + (size_t)myq * 1024 + head * 64 + 32 * dt + 8 * rq + 4 * hi, o);
            }
    }
}

__device__ __forceinline__ void phase_gmlp(const Ctx& c) {
    constexpr int VS = 136;
    LAS bf16_t* sVT = (LAS bf16_t*)c.lds;
    LAS float* st = (LAS float*)(c.lds + 128 * VS * 2);
    const float* lng = c.p.in[I_BLNG]; const float* lnb = c.p.in[I_BLNB]; const float* bs = c.p.in[I_BBS];
    const int fr = c.lane & 15, fq = c.lane >> 4;
    for (int u = c.bid; u < 130 * 8; u += c.nb) {
        const int chunk = u >> 3, g = u & 7;
        const int row0 = chunk < 128 ? chunk * 128 : L + (chunk - 128) * 128;
        __syncthreads();
        for (int i = 0; i < 16; ++i) {
            const int r = c.wid * 16 + i;
            const bf16_t* vp = c.Y1 + (size_t)(row0 + r) * 2048 + 1024 + c.lane * 16;
            const u32x4 a = *(const u32x4*)vp, b = *(const u32x4*)(vp + 8);
            float x[16] = {bflo(a.x), bfhi(a.x), bflo(a.y), bfhi(a.y), bflo(a.z), bfhi(a.z), bflo(a.w), bfhi(a.w),
                           bflo(b.x), bfhi(b.x), bflo(b.y), bfhi(b.y), bflo(b.z), bfhi(b.z), bflo(b.w), bfhi(b.w)};
            float s = 0.f;
#pragma unroll
            for (int e = 0; e < 16; ++e) s += x[e];
            const float mean = wave_sum(s) * (1.0f / 1024.0f);
            float q = 0.f;
#pragma unroll
            for (int e = 0; e < 16; ++e) { const float d = x[e] - mean; q += d * d; }
            const float var = wave_sum(q) * (1.0f / 1024.0f);
            if (c.lane == 0) { st[2 * r] = mean; st[2 * r + 1] = rsqrtf(var + LN_EPS); }
        }
        __syncthreads();
        {
            const int q = c.tid >> 2;
            const float mean = st[2 * q], rstd = st[2 * q + 1];
#pragma unroll
            for (int i = 0; i < 4; ++i) {
                const int cc = ((c.tid & 3) * 4 + i) * 8;
                const u32x4 a = *(const u32x4*)(c.Y1 + (size_t)(row0 + q) * 2048 + 1024 + g * 128 + cc);
                const float x[8] = {bflo(a.x), bfhi(a.x), bflo(a.y), bfhi(a.y), bflo(a.z), bfhi(a.z), bflo(a.w), bfhi(a.w)};
#pragma unroll
                for (int e = 0; e < 8; ++e) {
                    const float vn = (x[e] - mean) * rstd * lng[g * 128 + cc + e] + lnb[g * 128 + cc + e];
                    sVT[(cc + e) * VS + q] = (bf16_t)(cvt_pk_bf16(vn, 0.f) & 0xffff);
                }
            }
        }
        __syncthreads();
        const int p0 = (c.wid >> 1) * 32, c0 = (c.wid & 1) * 64;
        f32x4 acc[2][4];
#pragma unroll
        for (int m = 0; m < 2; ++m)
#pragma unroll
            for (int n = 0; n < 4; ++n) acc[m][n] = (f32x4){0.f, 0.f, 0.f, 0.f};
#pragma unroll
        for (int ks = 0; ks < 4; ++ks) {
            bf16x8 af[2], bfr[4];
#pragma unroll
            for (int m = 0; m < 2; ++m) af[m] = *(const bf16x8*)(c.wbs + (size_t)(g * 128 + p0 + m * 16 + fr) * 128 + ks * 32 + fq * 8);
#pragma unroll
            for (int n = 0; n < 4; ++n) bfr[n] = *(const LAS bf16x8*)(sVT + (c0 + n * 16 + fr) * VS + ks * 32 + fq * 8);
#pragma unroll
            for (int m = 0; m < 2; ++m)
#pragma unroll
                for (int n = 0; n < 4; ++n) acc[m][n] = __builtin_amdgcn_mfma_f32_16x16x32_bf16(bfr[n], af[m], acc[m][n], 0, 0, 0);
        }
#pragma unroll
        for (int m = 0; m < 2; ++m) {
            const int pp = p0 + m * 16 + fr;
            const float bias = bs[pp * 8 + g];
#pragma unroll
            for (int n = 0; n < 4; ++n) {
                const int cc = g * 128 + c0 + n * 16 + fq * 4;
                const u32x2 uu = *(const u32x2*)(c.Y1 + (size_t)(row0 + pp) * 2048 + cc);
                f32x4 o; o[0] = bflo(uu.x) * (acc[m][n][0] + bias); o[1] = bfhi(uu.x) * (acc[m][n][1] + bias);
                o[2] = bflo(uu.y) * (acc[m][n][2] + bias); o[3] = bfhi(uu.y) * (acc[m][n][3] + bias);
                store_bf16x4(c.MID + (size_t)(row0 + pp) * 1024 + cc, o);
            }
        }
    }
}

__device__ __forceinline__ void phase_conv(const Ctx& c) {
    const float* wc = c.p.in[I_CWCONV];
    const int ch = c.lane * 16;
    const int rpb = T / 256;
    for (int i = c.wid; i < rpb; i += 8) {
        const int row = c.bid * rpb + i;
        const bool hasp = (row != 0) && (row != L), hasn = (row != L - 1) && (row != T - 1);
        float zc[16];
#pragma unroll
        for (int e = 0; e < 16; ++e) zc[e] = 0.f;
#pragma unroll
        for (int t = 0; t < 3; ++t) {
            const bool ok = (t == 1) || (t == 0 ? hasp : hasn);
            if (ok) {
                const bf16_t* rp = c.Y1 + (size_t)(row + t - 1) * 3072;
#pragma unroll
                for (int hv = 0; hv < 2; ++hv) {
                    const u32x4 gcv = *(const u32x4*)(rp + 1024 + ch + hv * 8), zv = *(const u32x4*)(rp + 2048 + ch + hv * 8);
                    const f32x4 w0 = *(const f32x4*)(wc + t * 1024 + ch + hv * 8), w1 = *(const f32x4*)(wc + t * 1024 + ch + hv * 8 + 4);
                    zc[hv * 8 + 0] += w0[0] * bflo(gcv.x) * bflo(zv.x); zc[hv * 8 + 1] += w0[1] * bfhi(gcv.x) * bfhi(zv.x);
                    zc[hv * 8 + 2] += w0[2] * bflo(gcv.y) * bflo(zv.y); zc[hv * 8 + 3] += w0[3] * bfhi(gcv.y) * bfhi(zv.y);
                    zc[hv * 8 + 4] += w1[0] * bflo(gcv.z) * bflo(zv.z); zc[hv * 8 + 5] += w1[1] * bfhi(gcv.z) * bfhi(zv.z);
                    zc[hv * 8 + 6] += w1[2] * bflo(gcv.w) * bflo(zv.w); zc[hv * 8 + 7] += w1[3] * bfhi(gcv.w) * bfhi(zv.w);
                }
            }
        }
        const bf16_t* rp = c.Y1 + (size_t)row * 3072 + ch;
#pragma unroll
        for (int hv = 0; hv < 2; ++hv) {
            const u32x4 gb = *(const u32x4*)(rp + hv * 8);
            u32x4 w;
            w.x = cvt_pk_bf16(bflo(gb.x) * zc[hv * 8 + 0], bfhi(gb.x) * zc[hv * 8 + 1]);
            w.y = cvt_pk_bf16(bflo(gb.y) * zc[hv * 8 + 2], bfhi(gb.y) * zc[hv * 8 + 3]);
            w.z = cvt_pk_bf16(bflo(gb.z) * zc[hv * 8 + 4], bfhi(gb.z) * zc[hv * 8 + 5]);
            w.w = cvt_pk_bf16(bflo(gb.w) * zc[hv * 8 + 6], bfhi(gb.w) * zc[hv * 8 + 7]);
            *(u32x4*)(c.MID + (size_t)row * 1024 + ch + hv * 8) = w;
        }
    }
}

__device__ __forceinline__ void phase_ln1(const Ctx& c, int layer, int nrows) {
    const Params& p = c.p;
    LAS float* rw = (LAS float*)c.lds;
    LAS float* mv = rw + 16 * 1024;
    LAS float* lg = mv + 6 * 1024;
    LAS int* hist = (LAS int*)(lg + 2 * 1024);
    LAS int* base = hist + 16;
    LAS int* rinfo = base + 16;
    __syncthreads();
    for (int i = c.tid; i < 16 * 1024; i += NTHREADS) { const int k = i >> 4, e = i & 15; rw[e * 1024 + k] = p.in[I_RW][i]; }
    load_mod(mv, c.modp, p.in[I_BMOD], layer, 2, 0); load_mod(mv + 1024, c.modp, p.in[I_BMOD], layer, 3, 0); load_mod(mv + 2048, c.modp, p.in[I_BMOD], layer, 4, 0);
    load_mod(mv + 3072, c.modp, p.in[I_BMOD], layer, 2, 1); load_mod(mv + 4096, c.modp, p.in[I_BMOD], layer, 3, 1); load_mod(mv + 5120, c.modp, p.in[I_BMOD], layer, 4, 1);
    for (int i = c.tid; i < 1024; i += NTHREADS) { lg[i] = p.in[I_LN1G][layer * 1024 + i]; lg[1024 + i] = p.in[I_LN1B][layer * 1024 + i]; }
    if (c.tid < 16) hist[c.tid] = 0;
    __syncthreads();
    const int rpb = nrows / 256;
    for (int i = c.wid; i < rpb; i += 8) {
        const int row = c.bid * rpb + i; const bool ic = row >= L;
        const float* xr = (layer == 0) ? (ic ? p.in[I_CTX] + (size_t)(row - L) * 1024 : p.in[I_X] + (size_t)row * 1024) : c.X + (size_t)row * 1024;
        LAS float* ga = mv + (ic ? 3072 : 0); LAS float* shf = ga + 1024; LAS float* scf = ga + 2048;
        float v[16];
        float s = 0.f;
#pragma unroll
        for (int j = 0; j < 4; ++j) {
            const int col = 4 * c.lane + 256 * j;
            const f32x4 x = *(const f32x4*)(xr + col);
            const u32x2 y = *(const u32x2*)(c.YL + (size_t)row * 1024 + col);
            v[4 * j + 0] = ALPHA * x[0] + ga[col + 0] * bflo(y.x); v[4 * j + 1] = ALPHA * x[1] + ga[col + 1] * bfhi(y.x);
            v[4 * j + 2] = ALPHA * x[2] + ga[col + 2] * bflo(y.y); v[4 * j + 3] = ALPHA * x[3] + ga[col + 3] * bfhi(y.y);
            s += (v[4 * j] + v[4 * j + 1]) + (v[4 * j + 2] + v[4 * j + 3]);
        }
        const float mean = wave_sum(s) * (1.0f / 1024.0f);
        float q = 0.f;
#pragma unroll
        for (int e = 0; e < 16; ++e) { const float d = v[e] - mean; q += d * d; }
        const float rstd = rsqrtf(wave_sum(q) * (1.0f / 1024.0f) + LN_EPS);
        float h[16];
#pragma unroll
        for (int j = 0; j < 4; ++j) {
            const int col = 4 * c.lane + 256 * j;
            f32x4 xn, hh;
#pragma unroll
            for (int e = 0; e < 4; ++e) {
                xn[e] = (v[4 * j + e] - mean) * rstd * lg[col + e] + lg[1024 + col + e];
                hh[e] = xn[e] * (1.0f + scf[col + e]) + shf[col + e];
                h[4 * j + e] = hh[e];
            }
            *(f32x4*)(c.X + (size_t)row * 1024 + col) = xn;
            store_bf16x4(c.H + (size_t)row * 1024 + col, hh);
        }
        float sg[16];
#pragma unroll
        for (int e = 0; e < 16; ++e) {
            float a = 0.f;
#pragma unroll
            for (int j = 0; j < 4; ++j) {
                const f32x4 w = *(const LAS f32x4*)(rw + e * 1024 + 4 * c.lane + 256 * j);
                a += h[4 * j] * w[0] + h[4 * j + 1] * w[1] + h[4 * j + 2] * w[2] + h[4 * j + 3] * w[3];
            }
            a = wave_sum(a);
            sg[e] = 1.0f / (1.0f + __expf(-a));
        }
        float ssel[16];
#pragma unroll
        for (int e = 0; e < 16; ++e) ssel[e] = sg[e] + p.in[I_RB][e];
        int bestg = 0; float bestgs = -INFINITY;
        int e0 = 0, e1 = 1; float u0 = 0.f, u1 = 0.f;
#pragma unroll
        for (int gq = 0; gq < 4; ++gq) {
            int i0 = 0; float v0 = ssel[4 * gq]; float w0 = sg[4 * gq];
#pragma unroll
            for (int k = 1; k < 4; ++k) if (ssel[4 * gq + k] > v0) { v0 = ssel[4 * gq + k]; i0 = k; w0 = sg[4 * gq + k]; }
            int i1 = -1; float v1 = -INFINITY; float w1 = 0.f;
#pragma unroll
            for (int k = 0; k < 4; ++k) if (k != i0 && ssel[4 * gq + k] > v1) { v1 = ssel[4 * gq + k]; i1 = k; w1 = sg[4 * gq + k]; }
            const float gs = v0 + v1;
            if (gs > bestgs) { bestgs = gs; bestg = gq; e0 = 4 * gq + i0; e1 = 4 * gq + i1; u0 = w0; u1 = w1; }
        }
        (void)bestg;
        if (c.lane == 0) {
            const int r0l = __hip_atomic_fetch_add(&hist[e0], 1, __ATOMIC_RELAXED, __HIP_MEMORY_SCOPE_WORKGROUP);
            const int r1l = __hip_atomic_fetch_add(&hist[e1], 1, __ATOMIC_RELAXED, __HIP_MEMORY_SCOPE_WORKGROUP);
            rinfo[4 * i + 0] = e0; rinfo[4 * i + 1] = r0l; rinfo[4 * i + 2] = e1; rinfo[4 * i + 3] = r1l;
            const float inv = 1.0f / (u0 + u1);
            c.asg[(size_t)row * 4 + 2] = __float_as_uint(u0 * inv);
            c.asg[(size_t)row * 4 + 3] = __float_as_uint(u1 * inv);
        }
    }
    __syncthreads();
    if (c.tid < 16) base[c.tid] = (int)__hip_atomic_fetch_add(&c.cnt[(layer * 16 + c.tid) * 32], (unsigned)hist[c.tid], __ATOMIC_RELAXED, __HIP_MEMORY_SCOPE_AGENT);
    __syncthreads();
    for (int i = c.tid; i < rpb; i += NTHREADS) {
        const int row = c.bid * rpb + i;
        const int e0 = rinfo[4 * i], s0 = base[e0] + rinfo[4 * i + 1], e1 = rinfo[4 * i + 2], s1 = base[e1] + rinfo[4 * i + 3];
        c.tok[(size_t)e0 * T + s0] = row; c.tok[(size_t)e1 * T + s1] = row;
        c.asg[(size_t)row * 4 + 0] = ((unsigned)e0 << 20) | (unsigned)s0;
        c.asg[(size_t)row * 4 + 1] = ((unsigned)e1 << 20) | (unsigned)s1;
    }
}

__device__ __forceinline__ void moe_tables(const Ctx& c, int layer, LAS int* tb) {
    __syncthreads();
    if (c.tid == 0) {
        int acc = 0;
        for (int e = 0; e < 16; ++e) {
            const int n = (int)__hip_atomic_load(&c.cnt[(layer * 16 + e) * 32], __ATOMIC_RELAXED, __HIP_MEMORY_SCOPE_AGENT);
            tb[e] = n; tb[16 + e] = acc; acc += (n + 255) >> 8;
        }
        tb[32] = acc;
    }
    __syncthreads();
}

__device__ __forceinline__ void phase_moe1(const Ctx& c, int layer) {
    LAS int* tb = (LAS int*)(c.lds + 65536);
    moe_tables(c, layer, tb);
    const int R = tb[32];
    for (int u = c.bid; u < R * 8; u += c.nb) {
        const int rt = u >> 3, ct = u & 7;
        int e = 0;
#pragma unroll
        for (int k = 1; k < 16; ++k) if (rt >= tb[16 + k]) e = k;
        const int s0 = (rt - tb[16 + e]) * 256;
        ARowGather ar{c.H, c.tok + (size_t)e * T + s0, tb[e] - s0};
        EpiSwiglu ep{c.HID + (size_t)rt * 256 * DEXP + ct * 64};
        gemm_tile_s(c.lds, ar, c.w13 + ((size_t)(layer * 16 + e) * 1024 + ct * 128) * 1024, 1024, ep);
    }
}
__device__ __forceinline__ void phase_moe2(const Ctx& c, int layer) {
    LAS int* tb = (LAS int*)(c.lds + 65536);
    moe_tables(c, layer, tb);
    const int R = tb[32];
    for (int u = c.bid; u < R * 8; u += c.nb) {
        const int rt = u >> 3, ct = u & 7;
        int e = 0;
#pragma unroll
        for (int k = 1; k < 16; ++k) if (rt >= tb[16 + k]) e = k;
        ARowDirect ar{c.HID + (size_t)rt * 256 * DEXP, DEXP};
        EpiPlain ep{c.YS + (size_t)rt * 256 * 1024 + ct * 128, 1024};
        gemm_tile_s(c.lds, ar, c.w2 + ((size_t)(layer * 16 + e) * 1024 + ct * 128) * DEXP, DEXP, ep);
    }
}

__device__ __forceinline__ void phase_ln2(const Ctx& c, int layer, int nrows) {
    const Params& p = c.p;
    LAS int* tb = (LAS int*)(c.lds + 65536);
    moe_tables(c, layer, tb);
    LAS float* mv = (LAS float*)c.lds;
    LAS float* lg = mv + 6 * 1024;
    load_mod(mv, c.modp, p.in[I_BMOD], layer, 5, 0); load_mod(mv + 1024, c.modp, p.in[I_BMOD], layer, 5, 1);
    if (layer < 3) {
        load_mod(mv + 2048, c.modp, p.in[I_BMOD], layer + 1, 0, 0); load_mod(mv + 3072, c.modp, p.in[I_BMOD], layer + 1, 1, 0);
        load_mod(mv + 4096, c.modp, p.in[I_BMOD], layer + 1, 0, 1); load_mod(mv + 5120, c.modp, p.in[I_BMOD], layer + 1, 1, 1);
    }
    for (int i = c.tid; i < 1024; i += NTHREADS) { lg[i] = p.in[I_LN2G][layer * 1024 + i]; lg[1024 + i] = p.in[I_LN2B][layer * 1024 + i]; }
    __syncthreads();
    const int rpb = nrows / 256;
    for (int i = c.wid; i < rpb; i += 8) {
        const int row = c.bid * rpb + i; const bool ic = row >= L;
        const unsigned a0 = c.asg[(size_t)row * 4], a1 = c.asg[(size_t)row * 4 + 1];
        const float g0 = __uint_as_float(c.asg[(size_t)row * 4 + 2]), g1 = __uint_as_float(c.asg[(size_t)row * 4 + 3]);
        const int e0 = a0 >> 20, e1 = a1 >> 20;
        const size_t p0 = (size_t)tb[16 + e0] * 256 + (a0 & 0xfffff), p1 = (size_t)tb[16 + e1] * 256 + (a1 & 0xfffff);
        LAS float* gf = mv + (ic ? 1024 : 0);
        float v[16]; float s = 0.f;
#pragma unroll
        for (int j = 0; j < 4; ++j) {
            const int col = 4 * c.lane + 256 * j;
            const f32x4 x = *(const f32x4*)(c.X + (size_t)row * 1024 + col);
            const u32x2 y0 = *(const u32x2*)(c.YS + p0 * 1024 + col), y1 = *(const u32x2*)(c.YS + p1 * 1024 + col);
            v[4 * j + 0] = ALPHA * x[0] + gf[col + 0] * (g0 * bflo(y0.x) + g1 * bflo(y1.x));
            v[4 * j + 1] = ALPHA * x[1] + gf[col + 1] * (g0 * bfhi(y0.x) + g1 * bfhi(y1.x));
            v[4 * j + 2] = ALPHA * x[2] + gf[col + 2] * (g0 * bflo(y0.y) + g1 * bflo(y1.y));
            v[4 * j + 3] = ALPHA * x[3] + gf[col + 3] * (g0 * bfhi(y0.y) + g1 * bfhi(y1.y));
            s += (v[4 * j] + v[4 * j + 1]) + (v[4 * j + 2] + v[4 * j + 3]);
        }
        const float mean = wave_sum(s) * (1.0f / 1024.0f);
        float q = 0.f;
#pragma unroll
        for (int e = 0; e < 16; ++e) { const float d = v[e] - mean; q += d * d; }
        const float rstd = rsqrtf(wave_sum(q) * (1.0f / 1024.0f) + LN_EPS);
        LAS float* sha = mv + (ic ? 4096 : 2048); LAS float* sca = sha + 1024;
#pragma unroll
        for (int j = 0; j < 4; ++j) {
            const int col = 4 * c.lane + 256 * j;
            f32x4 xn;
#pragma unroll
            for (int e = 0; e < 4; ++e) xn[e] = (v[4 * j + e] - mean) * rstd * lg[col + e] + lg[1024 + col + e];
            if (layer < 3) {
                *(f32x4*)(c.X + (size_t)row * 1024 + col) = xn;
                f32x4 hh;
#pragma unroll
                for (int e = 0; e < 4; ++e) hh[e] = xn[e] * (1.0f + sca[col + e]) + sha[col + e];
                store_bf16x4(c.H + (size_t)row * 1024 + col, hh);
            } else {
                *(f32x4*)(p.out + (size_t)row * 1024 + col) = xn;
            }
        }
    }
}

template <int LAYER>
__device__ __forceinline__ void layer_fwd(const Ctx& c, const XcdBarrier& bar) {
    constexpr int KIND = LAYER % 3, J = LAYER / 3;
    constexpr bool WANT_CTX = LAYER < DEPTH - 1;
    constexpr int NROWS = WANT_CTX ? T : L;
    phase_g1<KIND>(c, J);
    xcd_barrier(bar);
    if constexpr (KIND == 0) phase_attn(c, c.p.in[I_ASINK] + J * 16, WANT_CTX);
    else if constexpr (KIND == 1) phase_gmlp(c);
    else phase_conv(c);
    xcd_barrier(bar);
    phase_g2(c, KIND == 0 ? c.wo + (size_t)J * 1024 * 1024 : (KIND == 1 ? c.wbout : c.wcout), NROWS);
    xcd_barrier(bar);
    phase_ln1(c, LAYER, NROWS);
    xcd_barrier(bar);
    phase_moe1(c, LAYER);
    xcd_barrier(bar);
    phase_moe2(c, LAYER);
    xcd_barrier(bar);
    phase_ln2(c, LAYER, NROWS);
    if constexpr (LAYER < DEPTH - 1) xcd_barrier(bar);
}

__global__ void __launch_bounds__(NTHREADS, 2) fwd_kernel(Params p) {
    extern __shared__ __attribute__((aligned(16))) unsigned char lds_raw[];
    Ctx c;
    c.p = p; c.lds = (LAS unsigned char*)lds_raw; c.bid = blockIdx.x; c.nb = gridDim.x; c.tid = threadIdx.x; c.wid = __builtin_amdgcn_readfirstlane(threadIdx.x >> 6); c.lane = threadIdx.x & 63;
    unsigned char* ws = p.ws; c.ws = ws;
    c.modp = (float*)(ws + WS_MODP); c.rope = (float*)(ws + WS_ROPE);
    c.wqkv = (bf16_t*)(ws + WS_WQKV); c.wo = (bf16_t*)(ws + WS_WO); c.wbin = (bf16_t*)(ws + WS_WBIN); c.wbs = (bf16_t*)(ws + WS_WBS); c.wbout = (bf16_t*)(ws + WS_WBOUT);
    c.wcin = (bf16_t*)(ws + WS_WCIN); c.wcout = (bf16_t*)(ws + WS_WCOUT); c.w13 = (bf16_t*)(ws + WS_W13); c.w2 = (bf16_t*)(ws + WS_W2);
    c.X = (float*)(ws + WS_X); c.H = (bf16_t*)(ws + WS_H); c.Y1 = (bf16_t*)(ws + WS_Y1); c.YS = c.Y1; c.MID = (bf16_t*)(ws + WS_MID); c.YL = (bf16_t*)(ws + WS_YL); c.HID = c.MID;
    c.tok = (int*)(ws + WS_TOK); c.asg = (unsigned*)(ws + WS_ASG); c.cnt = (unsigned*)(ws + WS_CTL) + CW_CNT;
    volatile LAS unsigned* bst = (volatile LAS unsigned*)(c.lds + LDS_BYTES - 16);
    if (c.tid == 0) { bst[0] = 0u; bst[1] = 0u; bst[2] = 0u; bst[3] = 0u; }
    __syncthreads();
    XcdBarrier bar = xcd_barrier_post((unsigned*)(ws + WS_CTL), bst);

    phase_prep(c);
    xcd_barrier(bar);
    phase_mod0(c);
    xcd_barrier(bar);
    layer_fwd<0>(c, bar);
    layer_fwd<1>(c, bar);
    layer_fwd<2>(c, bar);
    layer_fwd<3>(c, bar);
}

extern "C" void kernel_launch(void* const* d_in, const int* in_sizes, int n_in, void* d_out, int out_size, void* d_ws, size_t ws_size, hipStream_t stream) {
    static int grid = 0;
    if (grid == 0) {
        if (n_in != 28 || out_size != L * D || ws_size < WS_END) fprintf(stderr, "kernel_launch: unexpected shapes: n_in %d out %d ws %zu (need %zu)\n", n_in, out_size, ws_size, (size_t)WS_END);
        int dev = 0, cus = 0, per_cu = 0;
        if (hipGetDevice(&dev) != hipSuccess || hipDeviceGetAttribute(&cus, hipDeviceAttributeMultiprocessorCount, dev) != hipSuccess) { grid = -1; return; }
        if (hipFuncSetAttribute((const void*)fwd_kernel, hipFuncAttributeMaxDynamicSharedMemorySize, LDS_BYTES) != hipSuccess) { fprintf(stderr, "kernel_launch: hipFuncSetAttribute failed\n"); grid = -1; return; }
        if (hipOccupancyMaxActiveBlocksPerMultiprocessor(&per_cu, (const void*)fwd_kernel, NTHREADS, LDS_BYTES) != hipSuccess || per_cu < 1)
            fprintf(stderr, "kernel_launch: occupancy query reports %d\n", per_cu);
        (void)hipGetLastError();
        grid = cus;
    }
    if (grid < 0) return;
    (void)in_sizes;
    hipMemsetAsync((char*)d_ws + WS_CTL, 0, CTL_BYTES, stream);
    Params p{};
    for (int i = 0; i < 28; ++i) p.in[i] = (const float*)d_in[i];
    p.out = (float*)d_out; p.ws = (unsigned char*)d_ws;
    hipLaunchKernelGGL(fwd_kernel, dim3(grid), dim3(NTHREADS), LDS_BYTES, stream, p);
}
```

```cpp
#include <hip/hip_runtime.h>
#include <cstdio>
#include <cstdint>

#define LAS __attribute__((address_space(3)))
typedef unsigned short bf16_t;
typedef short bf16x8 __attribute__((ext_vector_type(8)));
typedef float f32x4 __attribute__((ext_vector_type(4)));
typedef float f32x16 __attribute__((ext_vector_type(16)));
typedef unsigned u32x4 __attribute__((ext_vector_type(4)));
typedef unsigned u32x2 __attribute__((ext_vector_type(2)));

constexpr int D = 1024, L = 16384, C = 256, T = L + C, DEPTH = 4;
constexpr int NEXP = 16, DEXP = 512;
constexpr int QKVW = 1536;
constexpr float ALPHA = 1.681792830507429f;
constexpr float LN_EPS = 1e-5f;
constexpr int NTHREADS = 512;
constexpr int LDS_BYTES = 147456;
constexpr int TB_OFF = 131072 + 1024;
constexpr int PMAX = 37632;

constexpr size_t al256(size_t x) { return (x + 255) & ~(size_t)255; }
constexpr size_t WS_CTL   = 0;
constexpr size_t CTL_BYTES = 32768;
constexpr size_t CW_CNT   = 4096;
constexpr size_t WS_MODP  = WS_CTL + CTL_BYTES;
constexpr size_t WS_ROPE  = WS_MODP + al256((size_t)4 * 8 * 2 * 6144 * 4);
constexpr size_t WS_WQKV  = WS_ROPE + (size_t)L * 64 * 4;
constexpr size_t WS_WO    = WS_WQKV + (size_t)2 * 1536 * 1024 * 2;
constexpr size_t WS_WBIN  = WS_WO + (size_t)2 * 1024 * 1024 * 2;
constexpr size_t WS_WBS   = WS_WBIN + (size_t)2048 * 1024 * 2;
constexpr size_t WS_WBOUT = WS_WBS + (size_t)8 * 128 * 128 * 2;
constexpr size_t WS_WCIN  = WS_WBOUT + (size_t)1024 * 1024 * 2;
constexpr size_t WS_WCOUT = WS_WCIN + (size_t)3072 * 1024 * 2;
constexpr size_t WS_W13   = WS_WCOUT + (size_t)1024 * 1024 * 2;
constexpr size_t WS_W2    = WS_W13 + (size_t)64 * 1024 * 1024 * 2;
constexpr size_t WS_X     = WS_W2 + (size_t)64 * 1024 * 512 * 2;
constexpr size_t WS_H     = WS_X + (size_t)T * 1024 * 4;
constexpr size_t WS_Y1    = WS_H + (size_t)T * 1024 * 2;
constexpr size_t WS_MID   = WS_Y1 + (size_t)T * 3072 * 2;
constexpr size_t WS_YL    = WS_MID + (size_t)T * 1024 * 2;
constexpr size_t WS_TOK   = WS_YL + (size_t)T * 1024 * 2 + 4 * 1024 * 1024;
constexpr size_t WS_ASG   = WS_TOK + (size_t)16 * T * 4;
constexpr size_t WS_END   = WS_ASG + (size_t)T * 16;
static_assert((size_t)PMAX * 1024 * 2 <= (size_t)T * 3072 * 2, "YS alias");
static_assert((size_t)PMAX * 512 * 2 <= (size_t)2 * T * 1024 * 2 + 4 * 1024 * 1024, "HID alias");

__device__ __forceinline__ unsigned cvt_pk_bf16(float lo, float hi) { unsigned r; asm volatile("v_cvt_pk_bf16_f32 %0, %1, %2" : "=v"(r) : "v"(lo), "v"(hi)); return r; }
__device__ __forceinline__ float bf2f(unsigned short b) { return __uint_as_float((unsigned)b << 16); }
__device__ __forceinline__ float bflo(unsigned w) { return __uint_as_float(w << 16); }
__device__ __forceinline__ float bfhi(unsigned w) { return __uint_as_float(w & 0xffff0000u); }
__device__ __forceinline__ float wave_sum(float v) {
#pragma unroll
    for (int o = 32; o > 0; o >>= 1) v += __shfl_xor(v, o);
    return v;
}
__device__ __forceinline__ float silu_f(float x) { return x / (1.0f + __expf(-x)); }
__device__ __forceinline__ float gelu_tanh_f(float x) {
    const float u = 0.7978845608028654f * (x + 0.044715f * x * x * x);
    const float e = __expf(2.0f * u);
    const float t = 1.0f - 2.0f / (e + 1.0f);
    return 0.5f * x * (1.0f + t);
}

#define XB_TMO      128
#define XB_XCNT(j)  (256  + 64 * (j))
#define XB_XSUB(j)  (1280 + 64 * (j))
#define XB_XGEN(j)  (2304 + 64 * (j))
#define XB_TOP      3328
#define XB_TOPGEN   3392
#define XCD_BAR_WORDS 3456
#define XB_SPIN_CAP (1u << 18)

__device__ __forceinline__ unsigned xb_ld(unsigned* p)              { return __hip_atomic_load(p, __ATOMIC_RELAXED, __HIP_MEMORY_SCOPE_AGENT); }
__device__ __forceinline__ unsigned xb_add(unsigned* p, unsigned v) { return __hip_atomic_fetch_add(p, v, __ATOMIC_RELAXED, __HIP_MEMORY_SCOPE_AGENT); }
__device__ __forceinline__ unsigned xb_xcc_id() { return (unsigned)__builtin_amdgcn_s_getreg((3 << 11) | 20) & 0xFu; }
#define XB_SPIN(cond, bar) do { unsigned _sp = 0; while (cond) { __builtin_amdgcn_s_sleep(1); \
    if ((++_sp & 255u) == 0u) { if (xb_ld(&(bar)[XB_TMO])) break; if (_sp > XB_SPIN_CAP) { atomicAdd(&(bar)[XB_TMO], 1u); break; } } } } while (0)

struct XcdBarrier { unsigned* bar; unsigned x; volatile LAS unsigned* st; };

__device__ __forceinline__ XcdBarrier xcd_barrier_post(unsigned* bar, volatile LAS unsigned* st) {
    XcdBarrier b; b.bar = bar; b.x = xb_xcc_id(); b.st = st;
    if (threadIdx.x == 0) (void)xb_add(&bar[XB_XCNT(b.x)], 1u);
    return b;
}
__device__ __forceinline__ void xcd_barrier_complete(unsigned* bar, unsigned x, unsigned& nloc, unsigned& nx) {
    const unsigned G = gridDim.x * gridDim.y * gridDim.z;
    unsigned sum, cnt, mine, sp = 0u;
    for (;;) {
        sum = 0u; cnt = 0u; mine = 0u;
#pragma unroll
        for (unsigned j = 0; j < 16; ++j) { const unsigned c = xb_ld(&bar[XB_XCNT(j)]); sum += c; cnt += (c > 0u) ? 1u : 0u; mine = (j == x) ? c : mine; }
        if (sum == G) break;
        __builtin_amdgcn_s_sleep(1);
        if ((++sp & 255u) == 0u) { if (xb_ld(&bar[XB_TMO])) break; if (sp > XB_SPIN_CAP) { atomicAdd(&bar[XB_TMO], 1u); break; } }
    }
    nloc = mine > 0u ? mine : 1u; nx = cnt > 0u ? cnt : 1u;
}
__device__ __forceinline__ void xcd_barrier(const XcdBarrier& b) {
    asm volatile("s_waitcnt vmcnt(0)" ::: "memory");
    __syncthreads();
    if (threadIdx.x == 0) {
        unsigned* bar = b.bar;
        __builtin_amdgcn_s_waitcnt(0);
        unsigned nloc = b.st[0], nx = b.st[1];
        if (nloc == 0u) { xcd_barrier_complete(bar, b.x, nloc, nx); b.st[0] = nloc; b.st[1] = nx; }
        const unsigned old = xb_add(&bar[XB_XSUB(b.x)], 1u);
        const unsigned gen = old / nloc;
        if (old + 1u == (gen + 1u) * nloc) {
            __builtin_amdgcn_fence(__ATOMIC_RELEASE, "agent");
            asm volatile("s_waitcnt vmcnt(0)" ::: "memory");
            const unsigned og = xb_add(&bar[XB_TOP], 1u);
            const unsigned tg = og / nx;
            if (og + 1u == (tg + 1u) * nx) xb_add(&bar[XB_TOPGEN], 1u);
            else XB_SPIN(xb_ld(&bar[XB_TOPGEN]) == tg, bar);
            __builtin_amdgcn_fence(__ATOMIC_ACQUIRE, "agent");
            xb_add(&bar[XB_XGEN(b.x)], 1u);
            asm volatile("s_waitcnt vmcnt(0)" ::: "memory");
        } else {
            XB_SPIN(xb_ld(&bar[XB_XGEN(b.x)]) == gen, bar);
            __builtin_amdgcn_fence(__ATOMIC_ACQUIRE, "agent");
            asm volatile("s_waitcnt vmcnt(0)" ::: "memory");
        }
    }
    __syncthreads();
}

struct Params {
    const float* in[28];
    float* out;
    unsigned char* ws;
};
enum { I_X = 0, I_C, I_CTX, I_CCTX, I_WMOD, I_BMOD, I_LN1G, I_LN1B, I_LN2G, I_LN2B, I_RW, I_RB, I_W1, I_W3, I_W2,
       I_AQKV, I_AO, I_ASINK, I_BWIN, I_BBIN, I_BLNG, I_BLNB, I_BWS, I_BBS, I_BWOUT, I_CWIN, I_CWCONV, I_CWOUT };

namespace g8 {
constexpr int BM = 256, BK = 64, HALF = 128, HTB = HALF * BK * 2, STAGE_BYTES = 8 * HTB, NXCD = 8, WGM = 8;
__device__ __forceinline__ int lds_byte(int r, int c) { const int st = (r >> 4) * 2 + (c >> 5), rr = r & 15, cc = c & 31, ob = rr * 64 + cc * 2; return st * 1024 + (ob ^ (((ob >> 9) & 1) << 5)); }
__device__ __forceinline__ void stage_rc(int b, int& R, int& C) { const int st = b / 1024, sb = b % 1024, swz = sb ^ (((sb >> 9) & 1) << 5); R = (st >> 1) * 16 + swz / 64; C = (st & 1) * 32 + (swz % 64) / 2; }
__device__ __forceinline__ int perm32(int rho) { const int n = rho >> 4, i = rho & 15; return 8 * (i >> 2) + 4 * n + (i & 3); }

struct Unit { const char* a; const char* b; int pm, pn, e; };

__device__ __forceinline__ bool order_next(int i, int G, int c, int nM, int nN, int& pm, int& pn) {
    const int nwg = nM * nN; const long Lq = (long)i * G + c; if (Lq >= nwg) return false;
    int wgid = (int)Lq; { const int q = nwg / NXCD, r = nwg % NXCD, xcd = wgid % NXCD, off = wgid / NXCD; wgid = (xcd < r ? xcd * (q + 1) : r * (q + 1) + (xcd - r) * q) + off; }
    const int nig = WGM * nN, gid = wgid / nig, fm = gid * WGM, gsz = (nM - fm) < WGM ? (nM - fm) : WGM;
    pm = fm + ((wgid % nig) % gsz); pn = (wgid % nig) / gsz; return true;
}

template <class Epi, class Sched, bool GATHER, bool ALIGN_EPI>
__device__ __forceinline__ void gemm8(LAS unsigned char* lds, const int K, const Sched& S, const Epi& E) {
    int tid_ = threadIdx.x; asm volatile("" : "+v"(tid_));
    const int tid = tid_, wid = __builtin_amdgcn_readfirstlane(tid >> 6), lane = tid & 63, wr = wid >> 2, wc = wid & 3, fr = lane & 15, fq = lane >> 4;
    const int nt = K / BK;
    unsigned voffA[2], voffB[2]; int stR[2], stC[2];
#pragma unroll
    for (int i = 0; i < 2; ++i) { int R, C; stage_rc(tid * 16 + i * 8192, R, C); const int Rb = (R & ~31) + perm32(R & 31);
        voffA[i] = (unsigned)(R * K + C) * 2u; voffB[i] = (unsigned)(Rb * K + C) * 2u; stR[i] = R; stC[i] = C; }
    const size_t kstep = (size_t)(BK * 2);
    const size_t hstep = (size_t)HALF * K * 2;
    const unsigned ldsw = (unsigned)wid * 1024u;
    const int aoff = lds_byte(wr * 64 + fr, fq * 8), boff = lds_byte(wc * 32 + fr, fq * 8);
#define G8_SA(b, h) (((b) * 2 + (h)) * HTB)
#define G8_SB(b, h) ((4 + (b) * 2 + (h)) * HTB)
#define G8_STAGE(bufoff, gbase, voff) do { _Pragma("unroll") for (int _i = 0; _i < 2; ++_i) \
        __builtin_amdgcn_global_load_lds((const unsigned*)((const char*)(gbase) + (voff)[_i]), (LAS unsigned*)(lds + (bufoff) + ldsw + _i * 8192), 16, 0, 0); } while (0)
#define G8_STAGE_A(bufoff, h, ap, OFFS) do { if constexpr (GATHER) { G8_STAGE(bufoff, ap, OFFS[h]); } else { G8_STAGE(bufoff, (ap) + (h) * hstep, voffA); } } while (0)
#define G8_LDA(dst, b, h) do { _Pragma("unroll") for (int m = 0; m < 4; ++m) _Pragma("unroll") for (int k = 0; k < 2; ++k) dst[m][k] = *(const LAS bf16x8*)(lds + G8_SA(b, h) + aoff + m * 2048 + k * 1024); } while (0)
#define G8_LDB(dst, b, h) do { _Pragma("unroll") for (int n = 0; n < 2; ++n) _Pragma("unroll") for (int k = 0; k < 2; ++k) dst[n][k] = *(const LAS bf16x8*)(lds + G8_SB(b, h) + boff + n * 2048 + k * 1024); } while (0)
#define G8_MMA(ai, bj, At, Bt) do { __builtin_amdgcn_s_setprio(1); _Pragma("unroll") for (int m = 0; m < 4; ++m) _Pragma("unroll") for (int n = 0; n < 2; ++n) _Pragma("unroll") for (int k = 0; k < 2; ++k) \
        acc[ai][bj][m][n] = __builtin_amdgcn_mfma_f32_16x16x32_bf16(Bt[n][k], At[m][k], acc[ai][bj][m][n], 0, 0, 0); __builtin_amdgcn_s_setprio(0); } while (0)
#define G8_WAIT_V(n) asm volatile("s_waitcnt vmcnt(" #n ")" ::: "memory")
#define G8_WAIT_L(n) asm volatile("s_waitcnt lgkmcnt(" #n ")" ::: "memory")
#define G8_BAR __builtin_amdgcn_s_barrier()
#define G8_SCHED __builtin_amdgcn_sched_barrier(0)
    Unit cur, nxt; int ui = 0;
    if (!S.next(0, cur)) return;
    f32x4 acc[2][2][4][2];
#pragma unroll
    for (int a = 0; a < 2; ++a)
#pragma unroll
        for (int b = 0; b < 2; ++b)
#pragma unroll
            for (int m = 0; m < 4; ++m)
#pragma unroll
                for (int n = 0; n < 2; ++n) acc[a][b][m][n] = (f32x4){0.f, 0.f, 0.f, 0.f};
    bf16x8 At[4][2], B0[2][2], B1[2][2];
    unsigned ac[2][2], an[2][2];
    if constexpr (GATHER) {
#pragma unroll
        for (int h = 0; h < 2; ++h)
#pragma unroll
            for (int i = 0; i < 2; ++i) { ac[h][i] = (unsigned)S.tokrow(cur, h * HALF + stR[i]) * (unsigned)(K * 2) + (unsigned)stC[i] * 2u; an[h][i] = ac[h][i]; }
    }
    const char* cA = cur.a; const char* cB = cur.b;
    G8_STAGE(G8_SB(0, 0), cB, voffB); G8_STAGE(G8_SB(0, 1), cB + hstep, voffB); G8_STAGE_A(G8_SA(0, 0), 0, cA, ac); G8_STAGE_A(G8_SA(0, 1), 1, cA, ac);
    if (wr == 1) G8_BAR;
    G8_WAIT_V(2); G8_BAR;
    G8_STAGE(G8_SB(1, 0), cB + kstep, voffB); G8_STAGE_A(G8_SA(1, 0), 0, cA + kstep, ac); G8_STAGE(G8_SB(1, 1), cB + hstep + kstep, voffB);
    G8_WAIT_V(6); G8_BAR;
    for (;;) {
        const bool has_next = S.next(ui + 1, nxt);
        const char* nA = has_next ? nxt.a : cA; const char* nB = has_next ? nxt.b : cB;
        if constexpr (GATHER) {
            if (has_next) {
#pragma unroll
                for (int h = 0; h < 2; ++h)
#pragma unroll
                    for (int i = 0; i < 2; ++i) an[h][i] = (unsigned)S.tokrow(nxt, h * HALF + stR[i]) * (unsigned)(K * 2) + (unsigned)stC[i] * 2u;
            }
        }
        for (int t = 0; t < nt; t += 2) {
            const bool last = (t == nt - 2);
            const char* a1 = cA + (size_t)(t + 1) * kstep;
            const char* a2 = last ? nA : cA + (size_t)(t + 2) * kstep; const char* b2 = last ? nB : cB + (size_t)(t + 2) * kstep;
            const char* a3 = a2 + kstep; const char* b3 = b2 + kstep;
            unsigned o2[2][2];
            if constexpr (GATHER) {
#pragma unroll
                for (int h = 0; h < 2; ++h)
#pragma unroll
                    for (int i = 0; i < 2; ++i) o2[h][i] = last ? an[h][i] : ac[h][i];
            }
            G8_LDB(B0, 0, 0); G8_LDB(B1, 0, 1); G8_SCHED; G8_LDA(At, 0, 0); G8_STAGE_A(G8_SA(1, 1), 1, a1, ac);
            G8_WAIT_V(8); G8_WAIT_L(0); G8_BAR; G8_MMA(0, 0, At, B0); G8_MMA(0, 1, At, B1); G8_BAR; G8_SCHED;
            G8_LDA(At, 0, 1); G8_STAGE(G8_SB(0, 0), b2, voffB); G8_STAGE(G8_SB(0, 1), b2 + hstep, voffB); G8_STAGE_A(G8_SA(0, 0), 0, a2, o2);
            G8_WAIT_V(8); G8_WAIT_L(0); G8_BAR; G8_MMA(1, 0, At, B0); G8_MMA(1, 1, At, B1); G8_BAR; G8_SCHED;
            G8_LDB(B0, 1, 0); G8_LDB(B1, 1, 1); G8_SCHED; G8_LDA(At, 1, 0); G8_STAGE_A(G8_SA(0, 1), 1, a2, o2);
            G8_WAIT_V(8); G8_WAIT_L(0); G8_BAR; G8_MMA(0, 0, At, B0); G8_MMA(0, 1, At, B1); G8_BAR; G8_SCHED;
            G8_LDA(At, 1, 1); G8_STAGE(G8_SB(1, 0), b3, voffB); G8_STAGE(G8_SB(1, 1), b3 + hstep, voffB); G8_STAGE_A(G8_SA(1, 0), 0, a3, o2);
            G8_WAIT_V(8); G8_WAIT_L(0); G8_BAR; G8_MMA(1, 0, At, B0); G8_MMA(1, 1, At, B1); G8_BAR; G8_SCHED;
        }
        if constexpr (ALIGN_EPI) { if (wr == 0) G8_BAR; }
        E(acc, cur, wr, wc, fr, fq);
        if (!has_next) break;
#pragma unroll
        for (int a = 0; a < 2; ++a)
#pragma unroll
            for (int b = 0; b < 2; ++b)
#pragma unroll
                for (int m = 0; m < 4; ++m)
#pragma unroll
                    for (int n = 0; n < 2; ++n) acc[a][b][m][n] = (f32x4){0.f, 0.f, 0.f, 0.f};
        cur = nxt; cA = nA; cB = nB; ++ui;
        if constexpr (GATHER) {
#pragma unroll
            for (int h = 0; h < 2; ++h)
#pragma unroll
                for (int i = 0; i < 2; ++i) ac[h][i] = an[h][i];
        }
        if constexpr (ALIGN_EPI) { if (wr == 1) G8_BAR; }
    }
    G8_WAIT_V(0);
    if constexpr (!ALIGN_EPI) { if (wr == 0) G8_BAR; }
    G8_BAR;
#undef G8_SA
#undef G8_SB
#undef G8_STAGE
#undef G8_STAGE_A
#undef G8_LDA
#undef G8_LDB
#undef G8_MMA
#undef G8_WAIT_V
#undef G8_WAIT_L
#undef G8_BAR
#undef G8_SCHED
}

typedef f32x4 Acc[2][2][4][2];
#define G8_EPI_LOOP(...) _Pragma("unroll") for (int ai = 0; ai < 2; ++ai) _Pragma("unroll") for (int m = 0; m < 4; ++m) _Pragma("unroll") for (int bj = 0; bj < 2; ++bj) { \
    const int rl = ai * HALF + wr * 64 + m * 16 + fr, cl = bj * HALF + wc * 32 + 8 * fq; const f32x4 v0 = acc[ai][bj][m][0], v1 = acc[ai][bj][m][1]; __VA_ARGS__ }
}

__device__ __forceinline__ void store_bf16x4(bf16_t* p, f32x4 v) { u32x2 w; w.x = cvt_pk_bf16(v[0], v[1]); w.y = cvt_pk_bf16(v[2], v[3]); *(u32x2*)p = w; }
__device__ __forceinline__ void store_bf16x8(bf16_t* p, f32x4 a, f32x4 b) { u32x4 w; w.x = cvt_pk_bf16(a[0], a[1]); w.y = cvt_pk_bf16(a[2], a[3]); w.z = cvt_pk_bf16(b[0], b[1]); w.w = cvt_pk_bf16(b[2], b[3]); *(u32x4*)p = w; }

struct E8Plain { bf16_t* O; int ldo;
    __device__ __forceinline__ void operator()(const g8::Acc& acc, const g8::Unit& u, int wr, int wc, int fr, int fq) const {
        using namespace g8;
        G8_EPI_LOOP({ store_bf16x8(O + (size_t)(u.pm * 256 + rl) * ldo + u.pn * 256 + cl, v0, v1); }) } };
struct E8Gelu { bf16_t* O; int ldo; const float* bias;
    __device__ __forceinline__ void operator()(const g8::Acc& acc, const g8::Unit& u, int wr, int wc, int fr, int fq) const {
        using namespace g8;
        G8_EPI_LOOP({ const int col = u.pn * 256 + cl; const f32x4 b0 = *(const f32x4*)(bias + col), b1 = *(const f32x4*)(bias + col + 4);
            f32x4 o0, o1;
            _Pragma("unroll") for (int e = 0; e < 4; ++e) { o0[e] = gelu_tanh_f(v0[e] + b0[e]); o1[e] = gelu_tanh_f(v1[e] + b1[e]); }
            store_bf16x8(O + (size_t)(u.pm * 256 + rl) * ldo + col, o0, o1); }) } };
struct E8Qkv { bf16_t* O; const float* rope;
    __device__ __forceinline__ void operator()(const g8::Acc& acc, const g8::Unit& u, int wr, int wc, int fr, int fq) const {
        using namespace g8;
        G8_EPI_LOOP({ const int row = u.pm * 256 + rl, col = u.pn * 256 + cl; f32x4 o0 = v0, o1 = v1;
            if (col < 1280 && row < L) {
                const float* tp = rope + (size_t)row * 64 + ((col & 63) >> 1);
                const f32x4 cs = *(const f32x4*)tp, sn = *(const f32x4*)(tp + 32);
                o0[0] = v0[0] * cs[0] - v0[1] * sn[0]; o0[1] = v0[1] * cs[0] + v0[0] * sn[0]; o0[2] = v0[2] * cs[1] - v0[3] * sn[1]; o0[3] = v0[3] * cs[1] + v0[2] * sn[1];
                o1[0] = v1[0] * cs[2] - v1[1] * sn[2]; o1[1] = v1[1] * cs[2] + v1[0] * sn[2]; o1[2] = v1[2] * cs[3] - v1[3] * sn[3]; o1[3] = v1[3] * cs[3] + v1[2] * sn[3];
            }
            store_bf16x8(O + (size_t)row * QKVW + col, o0, o1); }) } };
struct E8Swiglu { bf16_t* O;
    __device__ __forceinline__ void operator()(const g8::Acc& acc, const g8::Unit& u, int wr, int wc, int fr, int fq) const {
        using namespace g8;
        G8_EPI_LOOP({ f32x4 h; h[0] = silu_f(v0[0]) * v0[1]; h[1] = silu_f(v0[2]) * v0[3]; h[2] = silu_f(v1[0]) * v1[1]; h[3] = silu_f(v1[2]) * v1[3];
            store_bf16x4(O + (size_t)(u.pm * 256 + rl) * DEXP + ((u.pn * 256 + cl) >> 1), h); }) } };

struct SchedPlain { const char* A; const char* Bt; size_t tstep; int nM, nN, G, c;
    __device__ __forceinline__ bool next(int i, g8::Unit& u) const { int pm, pn; if (!g8::order_next(i, G, c, nM, nN, pm, pn)) return false;
        u.pm = pm; u.pn = pn; u.e = 0; u.a = A + (size_t)pm * tstep; u.b = Bt + (size_t)pn * tstep; return true; }
    __device__ __forceinline__ int tokrow(const g8::Unit&, int) const { return 0; } };
struct SchedMoe { const char* A; size_t atstep; const char* W; size_t wexp, btstep; const int* tok; LAS int* tb; int R, G, c;
    __device__ __forceinline__ bool next(int i, g8::Unit& u) const { int pm, pn; if (!g8::order_next(i, G, c, R, 4, pm, pn)) return false;
        int e = 0;
#pragma unroll
        for (int k = 1; k < 16; ++k) if (pm >= tb[16 + k]) e = k;
        e = __builtin_amdgcn_readfirstlane(e);
        u.pm = pm; u.pn = pn; u.e = e; u.a = A + (size_t)pm * atstep; u.b = W + (size_t)e * wexp + (size_t)pn * btstep; return true; }
    __device__ __forceinline__ int tokrow(const g8::Unit& u, int r) const { const int slot = (u.pm - tb[16 + u.e]) * 256 + r; return slot < tb[u.e] ? tok[(size_t)u.e * T + slot] : 0; } };

__device__ __forceinline__ void load_mod(LAS float* dst, const float* modp, const float* bmod, int layer, int chunk, int vec) {
    for (int j = threadIdx.x; j < 1024; j += NTHREADS) {
        float s = bmod[layer * 6144 + chunk * 1024 + j];
#pragma unroll
        for (int ks = 0; ks < 8; ++ks) s += modp[(((size_t)layer * 8 + ks) * 2 + vec) * 6144 + chunk * 1024 + j];
        dst[j] = s;
    }
}

__device__ __forceinline__ void cvt_tile(LAS unsigned char* lds, const float* src, const float* src2, int ldsrc, int mode, bf16_t* dst, int ldd, int n0, int k0) {
    LAS float* tf = (LAS float*)lds;
    const int tid = threadIdx.x;
    __syncthreads();
    {
        const int nl = tid & 63, kq = tid >> 6, n = n0 + nl;
        const float* s = src; int col = n;
        if (mode == 1) { if (n < 1280) { const int jn = n & 63, blk = jn >> 5, i = jn & 31; col = (n & ~63) + blk * 32 + (i & 1) * 16 + (i >> 1); } }
        else if (mode == 2) { s = (n & 1) ? src2 : src; col = n >> 1; }
#pragma unroll
        for (int j = 0; j < 8; ++j) { const int kk = kq + 8 * j; tf[kk * 65 + nl] = s[(size_t)(k0 + kk) * ldsrc + col]; }
    }
    __syncthreads();
    const int n = tid >> 3, kb = (tid & 7) * 8;
    float v[8];
#pragma unroll
    for (int j = 0; j < 8; ++j) v[j] = tf[(kb + j) * 65 + n];
    u32x4 w; w.x = cvt_pk_bf16(v[0], v[1]); w.y = cvt_pk_bf16(v[2], v[3]); w.z = cvt_pk_bf16(v[4], v[5]); w.w = cvt_pk_bf16(v[6], v[7]);
    *(u32x4*)(dst + (size_t)(n0 + n) * ldd + k0 + kb) = w;
}

#define PHASE_IDS int tid_ = threadIdx.x; asm volatile("" : "+v"(tid_)); const int tid = tid_, lane = tid & 63, wid = __builtin_amdgcn_readfirstlane(tid >> 6); (void)lane; (void)wid;
struct Ctx {
    Params p; LAS unsigned char* lds; int bid, nb;
    unsigned char* ws;
    float* modp; float* rope; bf16_t *wqkv, *wo, *wbin, *wbs, *wbout, *wcin, *wcout, *w13, *w2;
    float* X; bf16_t *H, *Y1, *MID, *YL, *HID, *YS; int* tok; unsigned* asg; unsigned* cnt;
};

__device__ __forceinline__ void phase_prep(const Ctx& c) {
    PHASE_IDS
    const Params& p = c.p;
    constexpr int T_QKV = 24 * 16, T_O = 16 * 16, T_BIN = 32 * 16, T_BOUT = 256, T_CIN = 48 * 16, T_COUT = 256, T_W13 = 256, T_W2 = 16 * 8;
    constexpr int S0 = 0, S1 = S0 + 2 * T_QKV, S2 = S1 + 2 * T_O, S3 = S2 + T_BIN, S4 = S3 + T_BOUT, S5 = S4 + T_CIN, S6 = S5 + T_COUT, S7 = S6 + 64 * T_W13, S8 = S7 + 64 * T_W2;
    for (int u = c.bid; u < S8; u += c.nb) {
        if (u < S1) { const int j = u / T_QKV, t = u % T_QKV; cvt_tile(c.lds, p.in[I_AQKV] + (size_t)j * 1024 * 1536, nullptr, 1536, 1, c.wqkv + (size_t)j * 1536 * 1024, 1024, (t / 16) * 64, (t % 16) * 64); }
        else if (u < S2) { const int v = u - S1, j = v / T_O, t = v % T_O; cvt_tile(c.lds, p.in[I_AO] + (size_t)j * 1024 * 1024, nullptr, 1024, 0, c.wo + (size_t)j * 1024 * 1024, 1024, (t / 16) * 64, (t % 16) * 64); }
        else if (u < S3) { const int t = u - S2; cvt_tile(c.lds, p.in[I_BWIN], nullptr, 2048, 0, c.wbin, 1024, (t / 16) * 64, (t % 16) * 64); }
        else if (u < S4) { const int t = u - S3; cvt_tile(c.lds, p.in[I_BWOUT], nullptr, 1024, 0, c.wbout, 1024, (t / 16) * 64, (t % 16) * 64); }
        else if (u < S5) { const int t = u - S4; cvt_tile(c.lds, p.in[I_CWIN], nullptr, 3072, 0, c.wcin, 1024, (t / 16) * 64, (t % 16) * 64); }
        else if (u < S6) { const int t = u - S5; cvt_tile(c.lds, p.in[I_CWOUT], nullptr, 1024, 0, c.wcout, 1024, (t / 16) * 64, (t % 16) * 64); }
        else if (u < S7) { const int v = u - S6, le = v / T_W13, t = v % T_W13;
            cvt_tile(c.lds, p.in[I_W1] + (size_t)le * 1024 * 512, p.in[I_W3] + (size_t)le * 1024 * 512, 512, 2, c.w13 + (size_t)le * 1024 * 1024, 1024, (t / 16) * 64, (t % 16) * 64); }
        else { const int v = u - S7, le = v / T_W2, t = v % T_W2;
            cvt_tile(c.lds, p.in[I_W2] + (size_t)le * 512 * 1024, nullptr, 1024, 0, c.w2 + (size_t)le * 1024 * 512, 512, (t / 8) * 64, (t % 8) * 64); }
    }
    for (int i = c.bid * NTHREADS + tid; i < 8 * 128 * 128 / 2; i += c.nb * NTHREADS) {
        const float a = p.in[I_BWS][2 * i], b = p.in[I_BWS][2 * i + 1];
        ((unsigned*)c.wbs)[i] = cvt_pk_bf16(a, b);
    }
    __syncthreads();
    LAS float* sl = (LAS float*)c.lds;
    for (int j = tid; j < 1024; j += NTHREADS) { sl[j] = silu_f(p.in[I_C][j]); sl[1024 + j] = silu_f(p.in[I_CCTX][j]); }
    __syncthreads();
    for (int u = c.bid; u < 4 * 12 * 8; u += c.nb) {
        const int layer = u / 96, r = u % 96, cc = r / 8, ks = r % 8;
        const int col = cc * 512 + tid;
        const float* w = p.in[I_WMOD] + (size_t)layer * 1024 * 6144 + (size_t)(ks * 128) * 6144 + col;
        float a0 = 0.f, a1 = 0.f;
#pragma unroll 8
        for (int k = 0; k < 128; ++k) { const float wv = w[(size_t)k * 6144]; a0 += sl[ks * 128 + k] * wv; a1 += sl[1024 + ks * 128 + k] * wv; }
        c.modp[(((size_t)layer * 8 + ks) * 2 + 0) * 6144 + col] = a0;
        c.modp[(((size_t)layer * 8 + ks) * 2 + 1) * 6144 + col] = a1;
    }
    for (int i = c.bid * NTHREADS + tid; i < L * 32; i += c.nb * NTHREADS) {
        const int pos = i >> 5, m = i & 31;
        const float freq = (float)pow(10000.0, -(double)(m & 15) / 16.0);
        const float ang = (float)((m < 16) ? (pos >> 6) : (pos & 63)) * freq;
        c.rope[(size_t)pos * 64 + m] = (float)cos((double)ang);
        c.rope[(size_t)pos * 64 + 32 + m] = (float)sin((double)ang);
    }
}

__device__ __forceinline__ void phase_mod0(const Ctx& c) {
    PHASE_IDS
    LAS float* mv = (LAS float*)c.lds;
    __syncthreads();
    load_mod(mv, c.modp, c.p.in[I_BMOD], 0, 0, 0); load_mod(mv + 1024, c.modp, c.p.in[I_BMOD], 0, 1, 0);
    load_mod(mv + 2048, c.modp, c.p.in[I_BMOD], 0, 0, 1); load_mod(mv + 3072, c.modp, c.p.in[I_BMOD], 0, 1, 1);
    __syncthreads();
    const int rpb = T / 256;
    for (int i = wid; i < rpb; i += 8) {
        const int row = c.bid * rpb + i; const bool ic = row >= L;
        const float* xr = ic ? c.p.in[I_CTX] + (size_t)(row - L) * 1024 : c.p.in[I_X] + (size_t)row * 1024;
        LAS float* sh = mv + (ic ? 2048 : 0); LAS float* sc = sh + 1024;
#pragma unroll
        for (int j = 0; j < 4; ++j) {
            const int col = 4 * lane + 256 * j;
            const f32x4 x = *(const f32x4*)(xr + col);
            f32x4 h;
#pragma unroll
            for (int e = 0; e < 4; ++e) h[e] = x[e] * (1.0f + sc[col + e]) + sh[col + e];
            store_bf16x4(c.H + (size_t)row * 1024 + col, h);
        }
    }
}

template <int KIND>
__device__ __forceinline__ void phase_g1(const Ctx& c, int j) {
    constexpr int N = KIND == 0 ? 1536 : (KIND == 1 ? 2048 : 3072);
    const bf16_t* W = KIND == 0 ? c.wqkv + (size_t)j * 1536 * 1024 : (KIND == 1 ? c.wbin : c.wcin);
    SchedPlain S{(const char*)c.H, (const char*)W, (size_t)256 * 1024 * 2, T / 256, N / 256, c.nb, c.bid};
    __syncthreads();
    if constexpr (KIND == 0) { E8Qkv e{c.Y1, c.rope}; g8::gemm8<E8Qkv, SchedPlain, false, true>(c.lds, 1024, S, e); }
    else if constexpr (KIND == 1) { E8Gelu e{c.Y1, N, c.p.in[I_BBIN]}; g8::gemm8<E8Gelu, SchedPlain, false, true>(c.lds, 1024, S, e); }
    else { E8Plain e{c.Y1, N}; g8::gemm8<E8Plain, SchedPlain, false, true>(c.lds, 1024, S, e); }
}
__device__ __forceinline__ void phase_g2(const Ctx& c, const bf16_t* W, int nrows) {
    SchedPlain S{(const char*)c.MID, (const char*)W, (size_t)256 * 1024 * 2, nrows / 256, 4, c.nb, c.bid};
    E8Plain e{c.YL, 1024};
    __syncthreads();
    g8::gemm8<E8Plain, SchedPlain, false, true>(c.lds, 1024, S, e);
}

__device__ __forceinline__ void phase_attn(const Ctx& c, const float* sink, bool ctxq) {
    PHASE_IDS
    constexpr int KS = 72, VS = 68;
    LAS bf16_t* sK = (LAS bf16_t*)c.lds;
    LAS bf16_t* sVT = sK + 64 * KS;
    const int g = wid >> 1, qh = wid & 1, ql = lane & 31, hi = lane >> 5;
    const int nqb = 256 + (ctxq ? 4 : 0);
    const float SC2 = 0.125f * 1.4426950408889634f;
    const int lkey = tid >> 3, lpc = tid & 7;
    for (int u = c.bid; u < nqb * 4; u += c.nb) {
        const int kvh = u / nqb, qb = u % nqb;
        const bool isctx = qb >= 256;
        const int qrow0 = isctx ? L + (qb - 256) * 64 : qb * 64;
        const int myq = qrow0 + qh * 32 + ql;
        const int head = kvh * 4 + g;
        bf16x8 qf[4];
#pragma unroll
        for (int s = 0; s < 4; ++s) qf[s] = *(const bf16x8*)(c.Y1 + (size_t)myq * QKVW + head * 64 + 16 * s + 8 * hi);
        float m_run = sink[head] * 1.4426950408889634f, l_run = (hi == 0) ? 1.0f : 0.0f;
        f32x16 oacc[2];
#pragma unroll
        for (int r = 0; r < 16; ++r) { oacc[0][r] = 0.f; oacc[1][r] = 0.f; }
        for (int ti = 0; ti < 9; ++ti) {
            int k0;
            if (ti < 5) { k0 = qrow0 - 128 + 64 * ti; if (isctx || k0 < 0 || k0 >= L) continue; }
            else k0 = L + 64 * (ti - 5);
            const u32x4 kr = *(const u32x4*)(c.Y1 + (size_t)(k0 + lkey) * QKVW + 1024 + kvh * 64 + lpc * 8);
            const u32x4 vr = *(const u32x4*)(c.Y1 + (size_t)(k0 + lkey) * QKVW + 1280 + kvh * 64 + lpc * 8);
            __syncthreads();
            *(LAS u32x4*)(sK + lkey * KS + lpc * 8) = kr;
            sVT[(lpc * 8 + 0) * VS + lkey] = (bf16_t)(vr.x & 0xffff); sVT[(lpc * 8 + 1) * VS + lkey] = (bf16_t)(vr.x >> 16);
            sVT[(lpc * 8 + 2) * VS + lkey] = (bf16_t)(vr.y & 0xffff); sVT[(lpc * 8 + 3) * VS + lkey] = (bf16_t)(vr.y >> 16);
            sVT[(lpc * 8 + 4) * VS + lkey] = (bf16_t)(vr.z & 0xffff); sVT[(lpc * 8 + 5) * VS + lkey] = (bf16_t)(vr.z >> 16);
            sVT[(lpc * 8 + 6) * VS + lkey] = (bf16_t)(vr.w & 0xffff); sVT[(lpc * 8 + 7) * VS + lkey] = (bf16_t)(vr.w >> 16);
            __syncthreads();
            f32x16 sacc[2];
#pragma unroll
            for (int r = 0; r < 16; ++r) { sacc[0][r] = 0.f; sacc[1][r] = 0.f; }
#pragma unroll
            for (int ks = 0; ks < 2; ++ks)
#pragma unroll
                for (int s = 0; s < 4; ++s) {
                    const bf16x8 kf = *(const LAS bf16x8*)(sK + (32 * ks + ql) * KS + 16 * s + 8 * hi);
                    sacc[ks] = __builtin_amdgcn_mfma_f32_32x32x16_bf16(kf, qf[s], sacc[ks], 0, 0, 0);
                }
            float mx = -INFINITY;
#pragma unroll
            for (int ks = 0; ks < 2; ++ks)
#pragma unroll
                for (int r = 0; r < 16; ++r) {
                    float v = sacc[ks][r] * SC2;
                    if (ti == 0 || ti == 4) {
                        const int kpos = k0 + 32 * ks + (r & 3) + 8 * (r >> 2) + 4 * hi;
                        const int dlt = kpos - myq;
                        if (dlt < -128 || dlt > 128) v = -INFINITY;
                    }
                    sacc[ks][r] = v; mx = fmaxf(mx, v);
                }
            mx = fmaxf(mx, __shfl_xor(mx, 32));
            const float m_new = fmaxf(m_run, mx);
            const float alpha = exp2f(m_run - m_new);
            m_run = m_new; l_run *= alpha;
#pragma unroll
            for (int r = 0; r < 16; ++r) { oacc[0][r] *= alpha; oacc[1][r] *= alpha; }
            float ls = 0.f;
            bf16x8 pb[2][2];
#pragma unroll
            for (int ks = 0; ks < 2; ++ks)
#pragma unroll
                for (int s2 = 0; s2 < 2; ++s2) {
                    float e[8];
#pragma unroll
                    for (int jj = 0; jj < 8; ++jj) { e[jj] = exp2f(sacc[ks][8 * s2 + jj] - m_new); ls += e[jj]; }
                    u32x4 w; w.x = cvt_pk_bf16(e[0], e[1]); w.y = cvt_pk_bf16(e[2], e[3]); w.z = cvt_pk_bf16(e[4], e[5]); w.w = cvt_pk_bf16(e[6], e[7]);
                    pb[ks][s2] = __builtin_bit_cast(bf16x8, w);
                }
            l_run += ls;
#pragma unroll
            for (int dt = 0; dt < 2; ++dt)
#pragma unroll
                for (int ks = 0; ks < 2; ++ks)
#pragma unroll
                    for (int s2 = 0; s2 < 2; ++s2) {
                        const int kb = 32 * ks + 16 * s2;
                        const u32x2 lo = *(const LAS u32x2*)(sVT + (32 * dt + ql) * VS + kb + 4 * hi);
                        const u32x2 hh = *(const LAS u32x2*)(sVT + (32 * dt + ql) * VS + kb + 8 + 4 * hi);
                        u32x4 w; w.x = lo.x; w.y = lo.y; w.z = hh.x; w.w = hh.y;
                        oacc[dt] = __builtin_amdgcn_mfma_f32_32x32x16_bf16(__builtin_bit_cast(bf16x8, w), pb[ks][s2], oacc[dt], 0, 0, 0);
                    }
        }
        const float lt = l_run + __shfl_xor(l_run, 32);
        const float inv = 1.0f / lt;
#pragma unroll
        for (int dt = 0; dt < 2; ++dt)
#pragma unroll
            for (int rq = 0; rq < 4; ++rq) {
                f32x4 o; o[0] = oacc[dt][4 * rq] * inv; o[1] = oacc[dt][4 * rq + 1] * inv; o[2] = oacc[dt][4 * rq + 2] * inv; o[3] = oacc[dt][4 * rq + 3] * inv;
                store_bf16x4(c.MID + (size_t)myq * 1024 + head * 64 + 32 * dt + 8 * rq + 4 * hi, o);
            }
    }
}

__device__ __forceinline__ void phase_gmlp(const Ctx& c) {
    PHASE_IDS
    constexpr int VS = 136;
    LAS bf16_t* sVT = (LAS bf16_t*)c.lds;
    LAS float* st = (LAS float*)(c.lds + 128 * VS * 2);
    const float* lng = c.p.in[I_BLNG]; const float* lnb = c.p.in[I_BLNB]; const float* bs = c.p.in[I_BBS];
    const int fr = lane & 15, fq = lane >> 4;
    for (int u = c.bid; u < 130 * 8; u += c.nb) {
        const int chunk = u >> 3, g = u & 7;
        const int row0 = chunk < 128 ? chunk * 128 : L + (chunk - 128) * 128;
        __syncthreads();
        for (int i = 0; i < 16; ++i) {
            const int r = wid * 16 + i;
            const bf16_t* vp = c.Y1 + (size_t)(row0 + r) * 2048 + 1024 + lane * 16;
            const u32x4 a = *(const u32x4*)vp, b = *(const u32x4*)(vp + 8);
            float x[16] = {bflo(a.x), bfhi(a.x), bflo(a.y), bfhi(a.y), bflo(a.z), bfhi(a.z), bflo(a.w), bfhi(a.w),
                           bflo(b.x), bfhi(b.x), bflo(b.y), bfhi(b.y), bflo(b.z), bfhi(b.z), bflo(b.w), bfhi(b.w)};
            float s = 0.f;
#pragma unroll
            for (int e = 0; e < 16; ++e) s += x[e];
            const float mean = wave_sum(s) * (1.0f / 1024.0f);
            float q = 0.f;
#pragma unroll
            for (int e = 0; e < 16; ++e) { const float d = x[e] - mean; q += d * d; }
            const float var = wave_sum(q) * (1.0f / 1024.0f);
            if (lane == 0) { st[2 * r] = mean; st[2 * r + 1] = rsqrtf(var + LN_EPS); }
        }
        __syncthreads();
        {
            const int q = tid >> 2;
            const float mean = st[2 * q], rstd = st[2 * q + 1];
#pragma unroll
            for (int i = 0; i < 4; ++i) {
                const int cc = ((tid & 3) * 4 + i) * 8;
                const u32x4 a = *(const u32x4*)(c.Y1 + (size_t)(row0 + q) * 2048 + 1024 + g * 128 + cc);
                const float x[8] = {bflo(a.x), bfhi(a.x), bflo(a.y), bfhi(a.y), bflo(a.z), bfhi(a.z), bflo(a.w), bfhi(a.w)};
#pragma unroll
                for (int e = 0; e < 8; ++e) {
                    const float vn = (x[e] - mean) * rstd * lng[g * 128 + cc + e] + lnb[g * 128 + cc + e];
                    sVT[(cc + e) * VS + q] = (bf16_t)(cvt_pk_bf16(vn, 0.f) & 0xffff);
                }
            }
        }
        __syncthreads();
        const int p0 = (wid >> 1) * 32, c0 = (wid & 1) * 64;
        f32x4 acc[2][4];
#pragma unroll
        for (int m = 0; m < 2; ++m)
#pragma unroll
            for (int n = 0; n < 4; ++n) acc[m][n] = (f32x4){0.f, 0.f, 0.f, 0.f};
#pragma unroll
        for (int ks = 0; ks < 4; ++ks) {
            bf16x8 af[2], bfr[4];
#pragma unroll
            for (int m = 0; m < 2; ++m) af[m] = *(const bf16x8*)(c.wbs + (size_t)(g * 128 + p0 + m * 16 + fr) * 128 + ks * 32 + fq * 8);
#pragma unroll
            for (int n = 0; n < 4; ++n) bfr[n] = *(const LAS bf16x8*)(sVT + (c0 + n * 16 + fr) * VS + ks * 32 + fq * 8);
#pragma unroll
            for (int m = 0; m < 2; ++m)
#pragma unroll
                for (int n = 0; n < 4; ++n) acc[m][n] = __builtin_amdgcn_mfma_f32_16x16x32_bf16(bfr[n], af[m], acc[m][n], 0, 0, 0);
        }
#pragma unroll
        for (int m = 0; m < 2; ++m) {
            const int pp = p0 + m * 16 + fr;
            const float bias = bs[pp * 8 + g];
#pragma unroll
            for (int n = 0; n < 4; ++n) {
                const int cc = g * 128 + c0 + n * 16 + fq * 4;
                const u32x2 uu = *(const u32x2*)(c.Y1 + (size_t)(row0 + pp) * 2048 + cc);
                f32x4 o; o[0] = bflo(uu.x) * (acc[m][n][0] + bias); o[1] = bfhi(uu.x) * (acc[m][n][1] + bias);
                o[2] = bflo(uu.y) * (acc[m][n][2] + bias); o[3] = bfhi(uu.y) * (acc[m][n][3] + bias);
                store_bf16x4(c.MID + (size_t)(row0 + pp) * 1024 + cc, o);
            }
        }
    }
}

__device__ __forceinline__ void phase_conv(const Ctx& c) {
    PHASE_IDS
    const float* wc = c.p.in[I_CWCONV];
    const int ch = lane * 16;
    const int rpb = T / 256;
    for (int i = wid; i < rpb; i += 8) {
        const int row = c.bid * rpb + i;
        const bool hasp = (row != 0) && (row != L), hasn = (row != L - 1) && (row != T - 1);
        float zc[16];
#pragma unroll
        for (int e = 0; e < 16; ++e) zc[e] = 0.f;
#pragma unroll
        for (int t = 0; t < 3; ++t) {
            const bool ok = (t == 1) || (t == 0 ? hasp : hasn);
            if (ok) {
                const bf16_t* rp = c.Y1 + (size_t)(row + t - 1) * 3072;
#pragma unroll
                for (int hv = 0; hv < 2; ++hv) {
                    const u32x4 gcv = *(const u32x4*)(rp + 1024 + ch + hv * 8), zv = *(const u32x4*)(rp + 2048 + ch + hv * 8);
                    const f32x4 w0 = *(const f32x4*)(wc + t * 1024 + ch + hv * 8), w1 = *(const f32x4*)(wc + t * 1024 + ch + hv * 8 + 4);
                    zc[hv * 8 + 0] += w0[0] * bflo(gcv.x) * bflo(zv.x); zc[hv * 8 + 1] += w0[1] * bfhi(gcv.x) * bfhi(zv.x);
                    zc[hv * 8 + 2] += w0[2] * bflo(gcv.y) * bflo(zv.y); zc[hv * 8 + 3] += w0[3] * bfhi(gcv.y) * bfhi(zv.y);
                    zc[hv * 8 + 4] += w1[0] * bflo(gcv.z) * bflo(zv.z); zc[hv * 8 + 5] += w1[1] * bfhi(gcv.z) * bfhi(zv.z);
                    zc[hv * 8 + 6] += w1[2] * bflo(gcv.w) * bflo(zv.w); zc[hv * 8 + 7] += w1[3] * bfhi(gcv.w) * bfhi(zv.w);
                }
            }
        }
        const bf16_t* rp = c.Y1 + (size_t)row * 3072 + ch;
#pragma unroll
        for (int hv = 0; hv < 2; ++hv) {
            const u32x4 gb = *(const u32x4*)(rp + hv * 8);
            u32x4 w;
            w.x = cvt_pk_bf16(bflo(gb.x) * zc[hv * 8 + 0], bfhi(gb.x) * zc[hv * 8 + 1]);
            w.y = cvt_pk_bf16(bflo(gb.y) * zc[hv * 8 + 2], bfhi(gb.y) * zc[hv * 8 + 3]);
            w.z = cvt_pk_bf16(bflo(gb.z) * zc[hv * 8 + 4], bfhi(gb.z) * zc[hv * 8 + 5]);
            w.w = cvt_pk_bf16(bflo(gb.w) * zc[hv * 8 + 6], bfhi(gb.w) * zc[hv * 8 + 7]);
            *(u32x4*)(c.MID + (size_t)row * 1024 + ch + hv * 8) = w;
        }
    }
}

__device__ __forceinline__ void phase_ln1(const Ctx& c, int layer, int nrows) {
    PHASE_IDS
    const Params& p = c.p;
    LAS float* rw = (LAS float*)c.lds;
    LAS float* mv = rw + 16 * 1024;
    LAS float* lg = mv + 6 * 1024;
    LAS int* hist = (LAS int*)(lg + 2 * 1024);
    LAS int* base = hist + 16;
    LAS int* rinfo = base + 16;
    __syncthreads();
    for (int i = tid; i < 16 * 1024; i += NTHREADS) { const int k = i >> 4, e = i & 15; rw[e * 1024 + k] = p.in[I_RW][i]; }
    load_mod(mv, c.modp, p.in[I_BMOD], layer, 2, 0); load_mod(mv + 1024, c.modp, p.in[I_BMOD], layer, 3, 0); load_mod(mv + 2048, c.modp, p.in[I_BMOD], layer, 4, 0);
    load_mod(mv + 3072, c.modp, p.in[I_BMOD], layer, 2, 1); load_mod(mv + 4096, c.modp, p.in[I_BMOD], layer, 3, 1); load_mod(mv + 5120, c.modp, p.in[I_BMOD], layer, 4, 1);
    for (int i = tid; i < 1024; i += NTHREADS) { lg[i] = p.in[I_LN1G][layer * 1024 + i]; lg[1024 + i] = p.in[I_LN1B][layer * 1024 + i]; }
    if (tid < 16) hist[tid] = 0;
    __syncthreads();
    const int rpb = nrows / 256;
    for (int i = wid; i < rpb; i += 8) {
        const int row = c.bid * rpb + i; const bool ic = row >= L;
        const float* xr = (layer == 0) ? (ic ? p.in[I_CTX] + (size_t)(row - L) * 1024 : p.in[I_X] + (size_t)row * 1024) : c.X + (size_t)row * 1024;
        LAS float* ga = mv + (ic ? 3072 : 0); LAS float* shf = ga + 1024; LAS float* scf = ga + 2048;
        float v[16];
        float s = 0.f;
#pragma unroll
        for (int j = 0; j < 4; ++j) {
            const int col = 4 * lane + 256 * j;
            const f32x4 x = *(const f32x4*)(xr + col);
            const u32x2 y = *(const u32x2*)(c.YL + (size_t)row * 1024 + col);
            v[4 * j + 0] = ALPHA * x[0] + ga[col + 0] * bflo(y.x); v[4 * j + 1] = ALPHA * x[1] + ga[col + 1] * bfhi(y.x);
            v[4 * j + 2] = ALPHA * x[2] + ga[col + 2] * bflo(y.y); v[4 * j + 3] = ALPHA * x[3] + ga[col + 3] * bfhi(y.y);
            s += (v[4 * j] + v[4 * j + 1]) + (v[4 * j + 2] + v[4 * j + 3]);
        }
        const float mean = wave_sum(s) * (1.0f / 1024.0f);
        float q = 0.f;
#pragma unroll
        for (int e = 0; e < 16; ++e) { const float d = v[e] - mean; q += d * d; }
        const float rstd = rsqrtf(wave_sum(q) * (1.0f / 1024.0f) + LN_EPS);
        float h[16];
#pragma unroll
        for (int j = 0; j < 4; ++j) {
            const int col = 4 * lane + 256 * j;
            f32x4 xn, hh;
#pragma unroll
            for (int e = 0; e < 4; ++e) {
                xn[e] = (v[4 * j + e] - mean) * rstd * lg[col + e] + lg[1024 + col + e];
                hh[e] = xn[e] * (1.0f + scf[col + e]) + shf[col + e];
                h[4 * j + e] = hh[e];
            }
            *(f32x4*)(c.X + (size_t)row * 1024 + col) = xn;
            store_bf16x4(c.H + (size_t)row * 1024 + col, hh);
        }
        float sg[16];
#pragma unroll
        for (int e = 0; e < 16; ++e) {
            float a = 0.f;
#pragma unroll
            for (int j = 0; j < 4; ++j) {
                const f32x4 w = *(const LAS f32x4*)(rw + e * 1024 + 4 * lane + 256 * j);
                a += h[4 * j] * w[0] + h[4 * j + 1] * w[1] + h[4 * j + 2] * w[2] + h[4 * j + 3] * w[3];
            }
            a = wave_sum(a);
            sg[e] = 1.0f / (1.0f + __expf(-a));
        }
        float ssel[16];
#pragma unroll
        for (int e = 0; e < 16; ++e) ssel[e] = sg[e] + p.in[I_RB][e];
        int bestg = 0; float bestgs = -INFINITY;
        int e0 = 0, e1 = 1; float u0 = 0.f, u1 = 0.f;
#pragma unroll
        for (int gq = 0; gq < 4; ++gq) {
            int i0 = 0; float v0 = ssel[4 * gq]; float w0 = sg[4 * gq];
#pragma unroll
            for (int k = 1; k < 4; ++k) if (ssel[4 * gq + k] > v0) { v0 = ssel[4 * gq + k]; i0 = k; w0 = sg[4 * gq + k]; }
            int i1 = -1; float v1 = -INFINITY; float w1 = 0.f;
#pragma unroll
            for (int k = 0; k < 4; ++k) if (k != i0 && ssel[4 * gq + k] > v1) { v1 = ssel[4 * gq + k]; i1 = k; w1 = sg[4 * gq + k]; }
            const float gs = v0 + v1;
            if (gs > bestgs) { bestgs = gs; bestg = gq; e0 = 4 * gq + i0; e1 = 4 * gq + i1; u0 = w0; u1 = w1; }
        }
        (void)bestg;
        if (lane == 0) {
            const int r0l = __hip_atomic_fetch_add(&hist[e0], 1, __ATOMIC_RELAXED, __HIP_MEMORY_SCOPE_WORKGROUP);
            const int r1l = __hip_atomic_fetch_add(&hist[e1], 1, __ATOMIC_RELAXED, __HIP_MEMORY_SCOPE_WORKGROUP);
            rinfo[4 * i + 0] = e0; rinfo[4 * i + 1] = r0l; rinfo[4 * i + 2] = e1; rinfo[4 * i + 3] = r1l;
            const float inv = 1.0f / (u0 + u1);
            c.asg[(size_t)row * 4 + 2] = __float_as_uint(u0 * inv);
            c.asg[(size_t)row * 4 + 3] = __float_as_uint(u1 * inv);
        }
    }
    __syncthreads();
    if (tid < 16) base[tid] = (int)__hip_atomic_fetch_add(&c.cnt[(layer * 16 + tid) * 32], (unsigned)hist[tid], __ATOMIC_RELAXED, __HIP_MEMORY_SCOPE_AGENT);
    __syncthreads();
    for (int i = tid; i < rpb; i += NTHREADS) {
        const int row = c.bid * rpb + i;
        const int e0 = rinfo[4 * i], s0 = base[e0] + rinfo[4 * i + 1], e1 = rinfo[4 * i + 2], s1 = base[e1] + rinfo[4 * i + 3];
        c.tok[(size_t)e0 * T + s0] = row; c.tok[(size_t)e1 * T + s1] = row;
        c.asg[(size_t)row * 4 + 0] = ((unsigned)e0 << 20) | (unsigned)s0;
        c.asg[(size_t)row * 4 + 1] = ((unsigned)e1 << 20) | (unsigned)s1;
    }
}

__device__ __forceinline__ void moe_tables(const Ctx& c, int layer, LAS int* tb) {
    PHASE_IDS
    __syncthreads();
    if (tid == 0) {
        int acc = 0;
        for (int e = 0; e < 16; ++e) {
            const int n = (int)__hip_atomic_load(&c.cnt[(layer * 16 + e) * 32], __ATOMIC_RELAXED, __HIP_MEMORY_SCOPE_AGENT);
            tb[e] = n; tb[16 + e] = acc; acc += (n + 255) >> 8;
        }
        tb[32] = acc;
    }
    __syncthreads();
}

__device__ __forceinline__ void phase_moe1(const Ctx& c, int layer) {
    LAS int* tb = (LAS int*)(c.lds + TB_OFF);
    moe_tables(c, layer, tb);
    SchedMoe S{(const char*)c.H, 0, (const char*)(c.w13 + (size_t)layer * 16 * 1024 * 1024), (size_t)1024 * 1024 * 2, (size_t)256 * 1024 * 2, c.tok, tb, __builtin_amdgcn_readfirstlane(tb[32]), c.nb, c.bid};
    E8Swiglu e{c.HID};
    g8::gemm8<E8Swiglu, SchedMoe, true, true>(c.lds, 1024, S, e);
}
__device__ __forceinline__ void phase_moe2(const Ctx& c, int layer) {
    LAS int* tb = (LAS int*)(c.lds + TB_OFF);
    moe_tables(c, layer, tb);
    SchedMoe S{(const char*)c.HID, (size_t)256 * DEXP * 2, (const char*)(c.w2 + (size_t)layer * 16 * 1024 * DEXP), (size_t)1024 * DEXP * 2, (size_t)256 * DEXP * 2, c.tok, tb, __builtin_amdgcn_readfirstlane(tb[32]), c.nb, c.bid};
    E8Plain e{c.YS, 1024};
    g8::gemm8<E8Plain, SchedMoe, false, true>(c.lds, DEXP, S, e);
}

__device__ __forceinline__ void phase_ln2(const Ctx& c, int layer, int nrows) {
    PHASE_IDS
    const Params& p = c.p;
    LAS int* tb = (LAS int*)(c.lds + TB_OFF);
    moe_tables(c, layer, tb);
    LAS float* mv = (LAS float*)c.lds;
    LAS float* lg = mv + 6 * 1024;
    load_mod(mv, c.modp, p.in[I_BMOD], layer, 5, 0); load_mod(mv + 1024, c.modp, p.in[I_BMOD], layer, 5, 1);
    if (layer < 3) {
        load_mod(mv + 2048, c.modp, p.in[I_BMOD], layer + 1, 0, 0); load_mod(mv + 3072, c.modp, p.in[I_BMOD], layer + 1, 1, 0);
        load_mod(mv + 4096, c.modp, p.in[I_BMOD], layer + 1, 0, 1); load_mod(mv + 5120, c.modp, p.in[I_BMOD], layer + 1, 1, 1);
    }
    for (int i = tid; i < 1024; i += NTHREADS) { lg[i] = p.in[I_LN2G][layer * 1024 + i]; lg[1024 + i] = p.in[I_LN2B][layer * 1024 + i]; }
    __syncthreads();
    const int rpb = nrows / 256;
    for (int i = wid; i < rpb; i += 8) {
        const int row = c.bid * rpb + i; const bool ic = row >= L;
        const unsigned a0 = c.asg[(size_t)row * 4], a1 = c.asg[(size_t)row * 4 + 1];
        const float g0 = __uint_as_float(c.asg[(size_t)row * 4 + 2]), g1 = __uint_as_float(c.asg[(size_t)row * 4 + 3]);
        const int e0 = a0 >> 20, e1 = a1 >> 20;
        const size_t p0 = (size_t)tb[16 + e0] * 256 + (a0 & 0xfffff), p1 = (size_t)tb[16 + e1] * 256 + (a1 & 0xfffff);
        LAS float* gf = mv + (ic ? 1024 : 0);
        float v[16]; float s = 0.f;
#pragma unroll
        for (int j = 0; j < 4; ++j) {
            const int col = 4 * lane + 256 * j;
            const f32x4 x = *(const f32x4*)(c.X + (size_t)row * 1024 + col);
            const u32x2 y0 = *(const u32x2*)(c.YS + p0 * 1024 + col), y1 = *(const u32x2*)(c.YS + p1 * 1024 + col);
            v[4 * j + 0] = ALPHA * x[0] + gf[col + 0] * (g0 * bflo(y0.x) + g1 * bflo(y1.x));
            v[4 * j + 1] = ALPHA * x[1] + gf[col + 1] * (g0 * bfhi(y0.x) + g1 * bfhi(y1.x));
            v[4 * j + 2] = ALPHA * x[2] + gf[col + 2] * (g0 * bflo(y0.y) + g1 * bflo(y1.y));
            v[4 * j + 3] = ALPHA * x[3] + gf[col + 3] * (g0 * bfhi(y0.y) + g1 * bfhi(y1.y));
            s += (v[4 * j] + v[4 * j + 1]) + (v[4 * j + 2] + v[4 * j + 3]);
        }
        const float mean = wave_sum(s) * (1.0f / 1024.0f);
        float q = 0.f;
#pragma unroll
        for (int e = 0; e < 16; ++e) { const float d = v[e] - mean; q += d * d; }
        const float rstd = rsqrtf(wave_sum(q) * (1.0f / 1024.0f) + LN_EPS);
        LAS float* sha = mv + (ic ? 4096 : 2048); LAS float* sca = sha + 1024;
#pragma unroll
        for (int j = 0; j < 4; ++j) {
            const int col = 4 * lane + 256 * j;
            f32x4 xn;
#pragma unroll
            for (int e = 0; e < 4; ++e) xn[e] = (v[4 * j + e] - mean) * rstd * lg[col + e] + lg[1024 + col + e];
            if (layer < 3) {
                *(f32x4*)(c.X + (size_t)row * 1024 + col) = xn;
                f32x4 hh;
#pragma unroll
                for (int e = 0; e < 4; ++e) hh[e] = xn[e] * (1.0f + sca[col + e]) + sha[col + e];
                store_bf16x4(c.H + (size_t)row * 1024 + col, hh);
            } else {
                *(f32x4*)(p.out + (size_t)row * 1024 + col) = xn;
            }
        }
    }
}

template <int LAYER>
__device__ __forceinline__ void layer_fwd(const Ctx& c, const XcdBarrier& bar) {
    constexpr int KIND = LAYER % 3, J = LAYER / 3;
    constexpr bool WANT_CTX = LAYER < DEPTH - 1;
    constexpr int NROWS = WANT_CTX ? T : L;
    phase_g1<KIND>(c, J);
    xcd_barrier(bar);
    if constexpr (KIND == 0) phase_attn(c, c.p.in[I_ASINK] + J * 16, WANT_CTX);
    else if constexpr (KIND == 1) phase_gmlp(c);
    else phase_conv(c);
    xcd_barrier(bar);
    phase_g2(c, KIND == 0 ? c.wo + (size_t)J * 1024 * 1024 : (KIND == 1 ? c.wbout : c.wcout), NROWS);
    xcd_barrier(bar);
    phase_ln1(c, LAYER, NROWS);
    xcd_barrier(bar);
    phase_moe1(c, LAYER);
    xcd_barrier(bar);
    phase_moe2(c, LAYER);
    xcd_barrier(bar);
    phase_ln2(c, LAYER, NROWS);
    if constexpr (LAYER < DEPTH - 1) xcd_barrier(bar);
}

__global__ void __launch_bounds__(NTHREADS, 2) fwd_kernel(Params p) {
    extern __shared__ __attribute__((aligned(16))) unsigned char lds_raw[];
    Ctx c;
    c.p = p; c.lds = (LAS unsigned char*)lds_raw; c.bid = blockIdx.x; c.nb = gridDim.x;
    unsigned char* ws = p.ws; c.ws = ws;
    c.modp = (float*)(ws + WS_MODP); c.rope = (float*)(ws + WS_ROPE);
    c.wqkv = (bf16_t*)(ws + WS_WQKV); c.wo = (bf16_t*)(ws + WS_WO); c.wbin = (bf16_t*)(ws + WS_WBIN); c.wbs = (bf16_t*)(ws + WS_WBS); c.wbout = (bf16_t*)(ws + WS_WBOUT);
    c.wcin = (bf16_t*)(ws + WS_WCIN); c.wcout = (bf16_t*)(ws + WS_WCOUT); c.w13 = (bf16_t*)(ws + WS_W13); c.w2 = (bf16_t*)(ws + WS_W2);
    c.X = (float*)(ws + WS_X); c.H = (bf16_t*)(ws + WS_H); c.Y1 = (bf16_t*)(ws + WS_Y1); c.YS = c.Y1; c.MID = (bf16_t*)(ws + WS_MID); c.YL = (bf16_t*)(ws + WS_YL); c.HID = c.MID;
    c.tok = (int*)(ws + WS_TOK); c.asg = (unsigned*)(ws + WS_ASG); c.cnt = (unsigned*)(ws + WS_CTL) + CW_CNT;
    volatile LAS unsigned* bst = (volatile LAS unsigned*)(c.lds + LDS_BYTES - 16);
    if (threadIdx.x == 0) { bst[0] = 0u; bst[1] = 0u; bst[2] = 0u; bst[3] = 0u; }
    __syncthreads();
    XcdBarrier bar = xcd_barrier_post((unsigned*)(ws + WS_CTL), bst);

    phase_prep(c);
    xcd_barrier(bar);
    phase_mod0(c);
    xcd_barrier(bar);
    layer_fwd<0>(c, bar);
    layer_fwd<1>(c, bar);
    layer_fwd<2>(c, bar);
    layer_fwd<3>(c, bar);
}

extern "C" void kernel_launch(void* const* d_in, const int* in_sizes, int n_in, void* d_out, int out_size, void* d_ws, size_t ws_size, hipStream_t stream) {
    static int grid = 0;
    if (grid == 0) {
        if (n_in != 28 || out_size != L * D || ws_size < WS_END) fprintf(stderr, "kernel_launch: unexpected shapes: n_in %d out %d ws %zu (need %zu)\n", n_in, out_size, ws_size, (size_t)WS_END);
        int dev = 0, cus = 0, per_cu = 0;
        if (hipGetDevice(&dev) != hipSuccess || hipDeviceGetAttribute(&cus, hipDeviceAttributeMultiprocessorCount, dev) != hipSuccess) { grid = -1; return; }
        if (hipFuncSetAttribute((const void*)fwd_kernel, hipFuncAttributeMaxDynamicSharedMemorySize, LDS_BYTES) != hipSuccess) { fprintf(stderr, "kernel_launch: hipFuncSetAttribute failed\n"); grid = -1; return; }
        if (hipOccupancyMaxActiveBlocksPerMultiprocessor(&per_cu, (const void*)fwd_kernel, NTHREADS, LDS_BYTES) != hipSuccess || per_cu < 1)
            fprintf(stderr, "kernel_launch: occupancy query reports %d\n", per_cu);
        (void)hipGetLastError();
        grid = cus;
    }
    if (grid < 0) return;
    (void)in_sizes;
    hipMemsetAsync((char*)d_ws + WS_CTL, 0, CTL_BYTES, stream);
    Params p{};
    for (int i = 0; i < 28; ++i) p.in[i] = (const float*)d_in[i];
    p.out = (float*)d_out; p.ws = (unsigned char*)d_ws;
    hipLaunchKernelGGL(fwd_kernel, dim3(grid), dim3(NTHREADS), LDS_BYTES, stream, p);
}
```

```cpp
#include <hip/hip_runtime.h>
#include <cstdio>
#include <cstdint>

#define LAS __attribute__((address_space(3)))
typedef unsigned short bf16_t;
typedef short bf16x8 __attribute__((ext_vector_type(8)));
typedef float f32x4 __attribute__((ext_vector_type(4)));
typedef float f32x16 __attribute__((ext_vector_type(16)));
typedef unsigned u32x4 __attribute__((ext_vector_type(4)));
typedef unsigned u32x2 __attribute__((ext_vector_type(2)));

constexpr int D = 1024, L = 16384, C = 256, T = L + C, DEPTH = 4;
constexpr int NEXP = 16, DEXP = 512;
constexpr int QKVW = 1536;
constexpr float ALPHA = 1.681792830507429f;
constexpr float LN_EPS = 1e-5f;
constexpr int NTHREADS = 512;
constexpr int LDS_BYTES = 147456;
constexpr int TB_OFF = 131072 + 1024;
constexpr int PMAX = 37632;

constexpr size_t al256(size_t x) { return (x + 255) & ~(size_t)255; }
constexpr size_t WS_CTL   = 0;
constexpr size_t CTL_BYTES = 32768;
constexpr size_t CW_CNT   = 4096;
constexpr size_t WS_MODP  = WS_CTL + CTL_BYTES;
constexpr size_t WS_MODF  = WS_MODP + al256((size_t)4 * 8 * 2 * 6144 * 4);
constexpr size_t WS_RWT   = WS_MODF + al256((size_t)4 * 2 * 6144 * 4);
constexpr size_t WS_ROPE  = WS_RWT + (size_t)16 * 1024 * 4;
constexpr size_t WS_WQKV  = WS_ROPE + (size_t)L * 64 * 4;
constexpr size_t WS_WO    = WS_WQKV + (size_t)2 * 1536 * 1024 * 2;
constexpr size_t WS_WBIN  = WS_WO + (size_t)2 * 1024 * 1024 * 2;
constexpr size_t WS_WBS   = WS_WBIN + (size_t)2048 * 1024 * 2;
constexpr size_t WS_WBOUT = WS_WBS + (size_t)8 * 128 * 128 * 2;
constexpr size_t WS_WCIN  = WS_WBOUT + (size_t)1024 * 1024 * 2;
constexpr size_t WS_WCOUT = WS_WCIN + (size_t)3072 * 1024 * 2;
constexpr size_t WS_W13   = WS_WCOUT + (size_t)1024 * 1024 * 2;
constexpr size_t WS_W2    = WS_W13 + (size_t)64 * 1024 * 1024 * 2;
constexpr size_t WS_X     = WS_W2 + (size_t)64 * 1024 * 512 * 2;
constexpr size_t WS_H     = WS_X + (size_t)T * 1024 * 4;
constexpr size_t WS_Y1    = WS_H + (size_t)T * 1024 * 2;
constexpr size_t WS_MID   = WS_Y1 + (size_t)T * 3072 * 2;
constexpr size_t WS_YL    = WS_MID + (size_t)T * 1024 * 2;
constexpr size_t WS_TOK   = WS_YL + (size_t)T * 1024 * 2 + 4 * 1024 * 1024;
constexpr size_t WS_ASG   = WS_TOK + (size_t)16 * T * 4;
constexpr size_t WS_END   = WS_ASG + (size_t)T * 16;
static_assert((size_t)PMAX * 1024 * 2 <= (size_t)T * 3072 * 2, "YS alias");
static_assert((size_t)PMAX * 512 * 2 <= (size_t)2 * T * 1024 * 2 + 4 * 1024 * 1024, "HID alias");

typedef __bf16 bf16x2_t __attribute__((ext_vector_type(2)));
typedef float f32x2_t __attribute__((ext_vector_type(2)));
__device__ __forceinline__ unsigned cvt_pk_bf16(float lo, float hi) { f32x2_t v = {lo, hi}; bf16x2_t b = __builtin_convertvector(v, bf16x2_t); return __builtin_bit_cast(unsigned, b); }
__device__ __forceinline__ float bf2f(unsigned short b) { return __uint_as_float((unsigned)b << 16); }
__device__ __forceinline__ float bflo(unsigned w) { return __uint_as_float(w << 16); }
__device__ __forceinline__ float bfhi(unsigned w) { return __uint_as_float(w & 0xffff0000u); }
__device__ __forceinline__ float wave_sum(float v) {
#pragma unroll
    for (int o = 32; o > 0; o >>= 1) v += __shfl_xor(v, o);
    return v;
}
__device__ __forceinline__ float silu_f(float x) { return x / (1.0f + __expf(-x)); }
__device__ __forceinline__ float gelu_tanh_f(float x) {
    const float u = 0.7978845608028654f * (x + 0.044715f * x * x * x);
    const float e = __expf(2.0f * u);
    const float t = 1.0f - 2.0f / (e + 1.0f);
    return 0.5f * x * (1.0f + t);
}

#define XB_TMO      128
#define XB_XCNT(j)  (256  + 64 * (j))
#define XB_XSUB(j)  (1280 + 64 * (j))
#define XB_XGEN(j)  (2304 + 64 * (j))
#define XB_TOP      3328
#define XB_TOPGEN   3392
#define XCD_BAR_WORDS 3456
#define XB_SPIN_CAP (1u << 18)

__device__ __forceinline__ unsigned xb_ld(unsigned* p)              { return __hip_atomic_load(p, __ATOMIC_RELAXED, __HIP_MEMORY_SCOPE_AGENT); }
__device__ __forceinline__ unsigned xb_add(unsigned* p, unsigned v) { return __hip_atomic_fetch_add(p, v, __ATOMIC_RELAXED, __HIP_MEMORY_SCOPE_AGENT); }
__device__ __forceinline__ unsigned xb_xcc_id() { return (unsigned)__builtin_amdgcn_s_getreg((3 << 11) | 20) & 0xFu; }
#define XB_SPIN(cond, bar) do { unsigned _sp = 0; while (cond) { __builtin_amdgcn_s_sleep(1); \
    if ((++_sp & 255u) == 0u) { if (xb_ld(&(bar)[XB_TMO])) break; if (_sp > XB_SPIN_CAP) { atomicAdd(&(bar)[XB_TMO], 1u); break; } } } } while (0)

struct XcdBarrier { unsigned* bar; unsigned x; volatile LAS unsigned* st; };

__device__ __forceinline__ XcdBarrier xcd_barrier_post(unsigned* bar, volatile LAS unsigned* st) {
    XcdBarrier b; b.bar = bar; b.x = xb_xcc_id(); b.st = st;
    if (threadIdx.x == 0) (void)xb_add(&bar[XB_XCNT(b.x)], 1u);
    return b;
}
__device__ __forceinline__ void xcd_barrier_complete(unsigned* bar, unsigned x, unsigned& nloc, unsigned& nx) {
    const unsigned G = gridDim.x * gridDim.y * gridDim.z;
    unsigned sum, cnt, mine, sp = 0u;
    for (;;) {
        sum = 0u; cnt = 0u; mine = 0u;
#pragma unroll
        for (unsigned j = 0; j < 16; ++j) { const unsigned c = xb_ld(&bar[XB_XCNT(j)]); sum += c; cnt += (c > 0u) ? 1u : 0u; mine = (j == x) ? c : mine; }
        if (sum == G) break;
        __builtin_amdgcn_s_sleep(1);
        if ((++sp & 255u) == 0u) { if (xb_ld(&bar[XB_TMO])) break; if (sp > XB_SPIN_CAP) { atomicAdd(&bar[XB_TMO], 1u); break; } }
    }
    nloc = mine > 0u ? mine : 1u; nx = cnt > 0u ? cnt : 1u;
}
__device__ __forceinline__ void xcd_barrier(const XcdBarrier& b) {
    asm volatile("s_waitcnt vmcnt(0)" ::: "memory");
    __syncthreads();
    if (threadIdx.x == 0) {
        unsigned* bar = b.bar;
        __builtin_amdgcn_s_waitcnt(0);
        unsigned nloc = b.st[0], nx = b.st[1];
        if (nloc == 0u) { xcd_barrier_complete(bar, b.x, nloc, nx); b.st[0] = nloc; b.st[1] = nx; }
        const unsigned old = xb_add(&bar[XB_XSUB(b.x)], 1u);
        const unsigned gen = old / nloc;
        if (old + 1u == (gen + 1u) * nloc) {
            __builtin_amdgcn_fence(__ATOMIC_RELEASE, "agent");
            asm volatile("s_waitcnt vmcnt(0)" ::: "memory");
            const unsigned og = xb_add(&bar[XB_TOP], 1u);
            const unsigned tg = og / nx;
            if (og + 1u == (tg + 1u) * nx) xb_add(&bar[XB_TOPGEN], 1u);
            else XB_SPIN(xb_ld(&bar[XB_TOPGEN]) == tg, bar);
            __builtin_amdgcn_fence(__ATOMIC_ACQUIRE, "agent");
            xb_add(&bar[XB_XGEN(b.x)], 1u);
            asm volatile("s_waitcnt vmcnt(0)" ::: "memory");
        } else {
            XB_SPIN(xb_ld(&bar[XB_XGEN(b.x)]) == gen, bar);
            __builtin_amdgcn_fence(__ATOMIC_ACQUIRE, "agent");
            asm volatile("s_waitcnt vmcnt(0)" ::: "memory");
        }
    }
    __syncthreads();
}

struct Params {
    const float* in[28];
    float* out;
    unsigned char* ws;
};
enum { I_X = 0, I_C, I_CTX, I_CCTX, I_WMOD, I_BMOD, I_LN1G, I_LN1B, I_LN2G, I_LN2B, I_RW, I_RB, I_W1, I_W3, I_W2,
       I_AQKV, I_AO, I_ASINK, I_BWIN, I_BBIN, I_BLNG, I_BLNB, I_BWS, I_BBS, I_BWOUT, I_CWIN, I_CWCONV, I_CWOUT };

namespace g8 {
constexpr int BM = 256, BK = 64, HALF = 128, HTB = HALF * BK * 2, STAGE_BYTES = 8 * HTB, NXCD = 8, WGM = 8;
__device__ __forceinline__ int lds_byte(int r, int c) { const int st = (r >> 4) * 2 + (c >> 5), rr = r & 15, cc = c & 31, ob = rr * 64 + cc * 2; return st * 1024 + (ob ^ (((ob >> 9) & 1) << 5)); }
__device__ __forceinline__ void stage_rc(int b, int& R, int& C) { const int st = b / 1024, sb = b % 1024, swz = sb ^ (((sb >> 9) & 1) << 5); R = (st >> 1) * 16 + swz / 64; C = (st & 1) * 32 + (swz % 64) / 2; }
__device__ __forceinline__ int perm32(int rho) { const int n = rho >> 4, i = rho & 15; return 8 * (i >> 2) + 4 * n + (i & 3); }

struct Unit { const char* a; const char* b; int pm, pn, e; };

__device__ __forceinline__ bool order_next(int i, int G, int c, int nM, int nN, int& pm, int& pn) {
    const int nwg = nM * nN; const long Lq = (long)i * G + c; if (Lq >= nwg) return false;
    int wgid = (int)Lq; { const int q = nwg / NXCD, r = nwg % NXCD, xcd = wgid % NXCD, off = wgid / NXCD; wgid = (xcd < r ? xcd * (q + 1) : r * (q + 1) + (xcd - r) * q) + off; }
    const int nig = WGM * nN, gid = wgid / nig, fm = gid * WGM, gsz = (nM - fm) < WGM ? (nM - fm) : WGM;
    pm = fm + ((wgid % nig) % gsz); pn = (wgid % nig) / gsz; return true;
}

template <class Epi, class Sched, bool GATHER, bool ALIGN_EPI>
__device__ __forceinline__ void gemm8(LAS unsigned char* lds, const int K, const Sched& S, const Epi& E) {
    int tid_ = threadIdx.x; asm volatile("" : "+v"(tid_));
    const int tid = tid_, wid = __builtin_amdgcn_readfirstlane(tid >> 6), lane = tid & 63, wr = wid >> 2, wc = wid & 3, fr = lane & 15, fq = lane >> 4;
    const int nt = K / BK;
    unsigned voffA[2], voffB[2]; int stR[2], stC[2];
#pragma unroll
    for (int i = 0; i < 2; ++i) { int R, C; stage_rc(tid * 16 + i * 8192, R, C); const int Rb = (R & ~31) + perm32(R & 31);
        voffA[i] = (unsigned)(R * K + C) * 2u; voffB[i] = (unsigned)(Rb * K + C) * 2u; stR[i] = R; stC[i] = C; }
    const size_t kstep = (size_t)(BK * 2);
    const size_t hstep = (size_t)HALF * K * 2;
    const unsigned ldsw = (unsigned)wid * 1024u;
    const int aoff = lds_byte(wr * 64 + fr, fq * 8), boff = lds_byte(wc * 32 + fr, fq * 8);
#define G8_SA(b, h) (((b) * 2 + (h)) * HTB)
#define G8_SB(b, h) ((4 + (b) * 2 + (h)) * HTB)
#define G8_STAGE(bufoff, gbase, voff) do { _Pragma("unroll") for (int _i = 0; _i < 2; ++_i) \
        __builtin_amdgcn_global_load_lds((const unsigned*)((const char*)(gbase) + (voff)[_i]), (LAS unsigned*)(lds + (bufoff) + ldsw + _i * 8192), 16, 0, 0); } while (0)
#define G8_STAGE_A(bufoff, h, ap, OFFS) do { if constexpr (GATHER) { G8_STAGE(bufoff, ap, OFFS[h]); } else { G8_STAGE(bufoff, (ap) + (h) * hstep, voffA); } } while (0)
#define G8_LDA(dst, b, h) do { _Pragma("unroll") for (int m = 0; m < 4; ++m) _Pragma("unroll") for (int k = 0; k < 2; ++k) dst[m][k] = *(const LAS bf16x8*)(lds + G8_SA(b, h) + aoff + m * 2048 + k * 1024); } while (0)
#define G8_LDB(dst, b, h) do { _Pragma("unroll") for (int n = 0; n < 2; ++n) _Pragma("unroll") for (int k = 0; k < 2; ++k) dst[n][k] = *(const LAS bf16x8*)(lds + G8_SB(b, h) + boff + n * 2048 + k * 1024); } while (0)
#define G8_MMA(ai, bj, At, Bt) do { __builtin_amdgcn_s_setprio(1); _Pragma("unroll") for (int m = 0; m < 4; ++m) _Pragma("unroll") for (int n = 0; n < 2; ++n) _Pragma("unroll") for (int k = 0; k < 2; ++k) \
        acc[ai][bj][m][n] = __builtin_amdgcn_mfma_f32_16x16x32_bf16(Bt[n][k], At[m][k], acc[ai][bj][m][n], 0, 0, 0); __builtin_amdgcn_s_setprio(0); } while (0)
#define G8_WAIT_V(n) asm volatile("s_waitcnt vmcnt(" #n ")" ::: "memory")
#define G8_WAIT_L(n) asm volatile("s_waitcnt lgkmcnt(" #n ")" ::: "memory")
#define G8_BAR __builtin_amdgcn_s_barrier()
#define G8_SCHED __builtin_amdgcn_sched_barrier(0)
    Unit cur, nxt; int ui = 0;
    if (!S.next(0, cur)) return;
    f32x4 acc[2][2][4][2];
#pragma unroll
    for (int a = 0; a < 2; ++a)
#pragma unroll
        for (int b = 0; b < 2; ++b)
#pragma unroll
            for (int m = 0; m < 4; ++m)
#pragma unroll
                for (int n = 0; n < 2; ++n) acc[a][b][m][n] = (f32x4){0.f, 0.f, 0.f, 0.f};
    bf16x8 At[4][2], B0[2][2], B1[2][2];
    unsigned ac[2][2], an[2][2];
    if constexpr (GATHER) {
#pragma unroll
        for (int h = 0; h < 2; ++h)
#pragma unroll
            for (int i = 0; i < 2; ++i) { ac[h][i] = (unsigned)S.tokrow(cur, h * HALF + stR[i]) * (unsigned)(K * 2) + (unsigned)stC[i] * 2u; an[h][i] = ac[h][i]; }
    }
    const char* cA = cur.a; const char* cB = cur.b;
    G8_STAGE(G8_SB(0, 0), cB, voffB); G8_STAGE(G8_SB(0, 1), cB + hstep, voffB); G8_STAGE_A(G8_SA(0, 0), 0, cA, ac); G8_STAGE_A(G8_SA(0, 1), 1, cA, ac);
    if (wr == 1) G8_BAR;
    G8_WAIT_V(2); G8_BAR;
    G8_STAGE(G8_SB(1, 0), cB + kstep, voffB); G8_STAGE_A(G8_SA(1, 0), 0, cA + kstep, ac); G8_STAGE(G8_SB(1, 1), cB + hstep + kstep, voffB);
    G8_WAIT_V(6); G8_BAR;
    for (;;) {
        const bool has_next = S.next(ui + 1, nxt);
        const char* nA = has_next ? nxt.a : cA; const char* nB = has_next ? nxt.b : cB;
        if constexpr (GATHER) {
            if (has_next) {
#pragma unroll
                for (int h = 0; h < 2; ++h)
#pragma unroll
                    for (int i = 0; i < 2; ++i) an[h][i] = (unsigned)S.tokrow(nxt, h * HALF + stR[i]) * (unsigned)(K * 2) + (unsigned)stC[i] * 2u;
            }
        }
        for (int t = 0; t < nt; t += 2) {
            const bool last = (t == nt - 2);
            const char* a1 = cA + (size_t)(t + 1) * kstep;
            const char* a2 = last ? nA : cA + (size_t)(t + 2) * kstep; const char* b2 = last ? nB : cB + (size_t)(t + 2) * kstep;
            const char* a3 = a2 + kstep; const char* b3 = b2 + kstep;
            unsigned o2[2][2];
            if constexpr (GATHER) {
#pragma unroll
                for (int h = 0; h < 2; ++h)
#pragma unroll
                    for (int i = 0; i < 2; ++i) o2[h][i] = last ? an[h][i] : ac[h][i];
            }
            G8_LDB(B0, 0, 0); G8_LDB(B1, 0, 1); G8_SCHED; G8_LDA(At, 0, 0); G8_STAGE_A(G8_SA(1, 1), 1, a1, ac);
            G8_WAIT_V(8); G8_WAIT_L(0); G8_BAR; G8_MMA(0, 0, At, B0); G8_MMA(0, 1, At, B1); G8_BAR; G8_SCHED;
            G8_LDA(At, 0, 1); G8_STAGE(G8_SB(0, 0), b2, voffB); G8_STAGE(G8_SB(0, 1), b2 + hstep, voffB); G8_STAGE_A(G8_SA(0, 0), 0, a2, o2);
            G8_WAIT_V(8); G8_WAIT_L(0); G8_BAR; G8_MMA(1, 0, At, B0); G8_MMA(1, 1, At, B1); G8_BAR; G8_SCHED;
            G8_LDB(B0, 1, 0); G8_LDB(B1, 1, 1); G8_SCHED; G8_LDA(At, 1, 0); G8_STAGE_A(G8_SA(0, 1), 1, a2, o2);
            G8_WAIT_V(8); G8_WAIT_L(0); G8_BAR; G8_MMA(0, 0, At, B0); G8_MMA(0, 1, At, B1); G8_BAR; G8_SCHED;
            G8_LDA(At, 1, 1); G8_STAGE(G8_SB(1, 0), b3, voffB); G8_STAGE(G8_SB(1, 1), b3 + hstep, voffB); G8_STAGE_A(G8_SA(1, 0), 0, a3, o2);
            G8_WAIT_V(8); G8_WAIT_L(0); G8_BAR; G8_MMA(1, 0, At, B0); G8_MMA(1, 1, At, B1); G8_BAR; G8_SCHED;
        }
        if constexpr (ALIGN_EPI) { if (wr == 0) G8_BAR; }
        E(acc, cur, wr, wc, fr, fq);
        if (!has_next) break;
#pragma unroll
        for (int a = 0; a < 2; ++a)
#pragma unroll
            for (int b = 0; b < 2; ++b)
#pragma unroll
                for (int m = 0; m < 4; ++m)
#pragma unroll
                    for (int n = 0; n < 2; ++n) acc[a][b][m][n] = (f32x4){0.f, 0.f, 0.f, 0.f};
        cur = nxt; cA = nA; cB = nB; ++ui;
        if constexpr (GATHER) {
#pragma unroll
            for (int h = 0; h < 2; ++h)
#pragma unroll
                for (int i = 0; i < 2; ++i) ac[h][i] = an[h][i];
        }
        if constexpr (ALIGN_EPI) { if (wr == 1) G8_BAR; }
    }
    G8_WAIT_V(0);
    if constexpr (!ALIGN_EPI) { if (wr == 0) G8_BAR; }
    G8_BAR;
#undef G8_SA
#undef G8_SB
#undef G8_STAGE
#undef G8_STAGE_A
#undef G8_LDA
#undef G8_LDB
#undef G8_MMA
#undef G8_WAIT_V
#undef G8_WAIT_L
#undef G8_BAR
#undef G8_SCHED
}

typedef f32x4 Acc[2][2][4][2];
#define G8_EPI_LOOP(...) _Pragma("unroll") for (int ai = 0; ai < 2; ++ai) _Pragma("unroll") for (int m = 0; m < 4; ++m) _Pragma("unroll") for (int bj = 0; bj < 2; ++bj) { \
    const int rl = ai * HALF + wr * 64 + m * 16 + fr, cl = bj * HALF + wc * 32 + 8 * fq; const f32x4 v0 = acc[ai][bj][m][0], v1 = acc[ai][bj][m][1]; __VA_ARGS__ }
}

__device__ __forceinline__ void store_bf16x4(bf16_t* p, f32x4 v) { u32x2 w; w.x = cvt_pk_bf16(v[0], v[1]); w.y = cvt_pk_bf16(v[2], v[3]); *(u32x2*)p = w; }
__device__ __forceinline__ void store_bf16x8(bf16_t* p, f32x4 a, f32x4 b) { u32x4 w; w.x = cvt_pk_bf16(a[0], a[1]); w.y = cvt_pk_bf16(a[2], a[3]); w.z = cvt_pk_bf16(b[0], b[1]); w.w = cvt_pk_bf16(b[2], b[3]); *(u32x4*)p = w; }

struct E8Plain { bf16_t* O; int ldo;
    __device__ __forceinline__ void operator()(const g8::Acc& acc, const g8::Unit& u, int wr, int wc, int fr, int fq) const {
        using namespace g8;
        G8_EPI_LOOP({ store_bf16x8(O + (size_t)(u.pm * 256 + rl) * ldo + u.pn * 256 + cl, v0, v1); }) } };
struct E8Gelu { bf16_t* O; int ldo; const float* bias;
    __device__ __forceinline__ void operator()(const g8::Acc& acc, const g8::Unit& u, int wr, int wc, int fr, int fq) const {
        using namespace g8;
        G8_EPI_LOOP({ const int col = u.pn * 256 + cl; const f32x4 b0 = *(const f32x4*)(bias + col), b1 = *(const f32x4*)(bias + col + 4);
            f32x4 o0, o1;
            _Pragma("unroll") for (int e = 0; e < 4; ++e) { o0[e] = gelu_tanh_f(v0[e] + b0[e]); o1[e] = gelu_tanh_f(v1[e] + b1[e]); }
            store_bf16x8(O + (size_t)(u.pm * 256 + rl) * ldo + col, o0, o1); }) } };
struct E8Qkv { bf16_t* O; const float* rope;
    __device__ __forceinline__ void operator()(const g8::Acc& acc, const g8::Unit& u, int wr, int wc, int fr, int fq) const {
        using namespace g8;
        G8_EPI_LOOP({ const int row = u.pm * 256 + rl, col = u.pn * 256 + cl; f32x4 o0 = v0, o1 = v1;
            if (col < 1280 && row < L) {
                const float* tp = rope + (size_t)row * 64 + ((col & 63) >> 1);
                const f32x4 cs = *(const f32x4*)tp, sn = *(const f32x4*)(tp + 32);
                o0[0] = v0[0] * cs[0] - v0[1] * sn[0]; o0[1] = v0[1] * cs[0] + v0[0] * sn[0]; o0[2] = v0[2] * cs[1] - v0[3] * sn[1]; o0[3] = v0[3] * cs[1] + v0[2] * sn[1];
                o1[0] = v1[0] * cs[2] - v1[1] * sn[2]; o1[1] = v1[1] * cs[2] + v1[0] * sn[2]; o1[2] = v1[2] * cs[3] - v1[3] * sn[3]; o1[3] = v1[3] * cs[3] + v1[2] * sn[3];
            }
            store_bf16x8(O + (size_t)row * QKVW + col, o0, o1); }) } };
struct E8Swiglu { bf16_t* O;
    __device__ __forceinline__ void operator()(const g8::Acc& acc, const g8::Unit& u, int wr, int wc, int fr, int fq) const {
        using namespace g8;
        G8_EPI_LOOP({ f32x4 h; h[0] = silu_f(v0[0]) * v0[1]; h[1] = silu_f(v0[2]) * v0[3]; h[2] = silu_f(v1[0]) * v1[1]; h[3] = silu_f(v1[2]) * v1[3];
            store_bf16x4(O + (size_t)(u.pm * 256 + rl) * DEXP + ((u.pn * 256 + cl) >> 1), h); }) } };

struct SchedPlain { const char* A; const char* Bt; size_t tstep; int nM, nN, G, c;
    __device__ __forceinline__ bool next(int i, g8::Unit& u) const { int pm, pn; if (!g8::order_next(i, G, c, nM, nN, pm, pn)) return false;
        u.pm = pm; u.pn = pn; u.e = 0; u.a = A + (size_t)pm * tstep; u.b = Bt + (size_t)pn * tstep; return true; }
    __device__ __forceinline__ int tokrow(const g8::Unit&, int) const { return 0; } };
struct SchedMoe { const char* A; size_t atstep; const char* W; size_t wexp, btstep; const int* tok; LAS int* tb; int R, G, c;
    __device__ __forceinline__ bool next(int i, g8::Unit& u) const { int pm, pn; if (!g8::order_next(i, G, c, R, 4, pm, pn)) return false;
        int e = 0;
#pragma unroll
        for (int k = 1; k < 16; ++k) if (pm >= tb[16 + k]) e = k;
        e = __builtin_amdgcn_readfirstlane(e);
        u.pm = pm; u.pn = pn; u.e = e; u.a = A + (size_t)pm * atstep; u.b = W + (size_t)e * wexp + (size_t)pn * btstep; return true; }
    __device__ __forceinline__ int tokrow(const g8::Unit& u, int r) const { const int slot = (u.pm - tb[16 + u.e]) * 256 + r; return slot < tb[u.e] ? tok[(size_t)u.e * T + slot] : 0; } };

__device__ __forceinline__ void load_mod(LAS float* dst, const float* modp, const float* bmod, int layer, int chunk, int vec) {
    for (int j = threadIdx.x; j < 1024; j += NTHREADS) {
        float s = bmod[layer * 6144 + chunk * 1024 + j];
#pragma unroll
        for (int ks = 0; ks < 8; ++ks) s += modp[(((size_t)layer * 8 + ks) * 2 + vec) * 6144 + chunk * 1024 + j];
        dst[j] = s;
    }
}

__device__ __forceinline__ void lds_copy(LAS float* dst, const float* src, int n, int tid) {
    for (int i = tid * 4; i < n; i += NTHREADS * 4) *(LAS f32x4*)(dst + i) = *(const f32x4*)(src + i);
}
__device__ __forceinline__ void cvt_tile_w(LAS float* tf  , const float* src, const float* src2, int ldsrc, int mode, bf16_t* dst, int ldd, int n0, int k0, int lane) {
    const int n = n0 + lane;
    const float* s = src; int col = n;
    if (mode == 1) { if (n < 1280) { const int jn = n & 63, blk = jn >> 5, i = jn & 31; col = (n & ~63) + blk * 32 + (i & 1) * 16 + (i >> 1); } }
    else if (mode == 2) { s = (n & 1) ? src2 : src; col = n >> 1; }
    const float* sp = s + (size_t)k0 * ldsrc + col;
#pragma unroll
    for (int hb = 0; hb < 2; ++hb) {
        float v[32];
#pragma unroll
        for (int j = 0; j < 32; ++j) v[j] = sp[(size_t)(hb * 32 + j) * ldsrc];
#pragma unroll
        for (int j = 0; j < 32; ++j) tf[(hb * 32 + j) * 65 + lane] = v[j];
    }
    const int kb = (lane & 7) * 8;
#pragma unroll
    for (int j = 0; j < 8; ++j) {
        const int nn = (lane >> 3) + 8 * j;
        float v[8];
#pragma unroll
        for (int i = 0; i < 8; ++i) v[i] = tf[(kb + i) * 65 + nn];
        u32x4 w; w.x = cvt_pk_bf16(v[0], v[1]); w.y = cvt_pk_bf16(v[2], v[3]); w.z = cvt_pk_bf16(v[4], v[5]); w.w = cvt_pk_bf16(v[6], v[7]);
        *(u32x4*)(dst + (size_t)(n0 + nn) * ldd + k0 + kb) = w;
    }
}

constexpr int RP_PREP_A = 1, RP_PREP_B = 1, RP_PREP_C = 1;
#define PHASE_IDS int tid_ = threadIdx.x; asm volatile("" : "+v"(tid_)); const int tid = tid_, lane = tid & 63, wid = __builtin_amdgcn_readfirstlane(tid >> 6); (void)lane; (void)wid;
struct Ctx {
    Params p; LAS unsigned char* lds; int bid, nb;
    unsigned char* ws;
    float* modp; float* modf; float* rwt; float* rope; bf16_t *wqkv, *wo, *wbin, *wbs, *wbout, *wcin, *wcout, *w13, *w2;
    float* X; bf16_t *H, *Y1, *MID, *YL, *HID, *YS; int* tok; unsigned* asg; unsigned* cnt;
};

__device__ __forceinline__ void phase_prep(const Ctx& c) {
    PHASE_IDS
    const Params& p = c.p;
    constexpr int T_QKV = 24 * 16, T_O = 16 * 16, T_BIN = 32 * 16, T_BOUT = 256, T_CIN = 48 * 16, T_COUT = 256, T_W13 = 256, T_W2 = 16 * 8;
    constexpr int S0 = 0, S1 = S0 + 2 * T_QKV, S2 = S1 + 2 * T_O, S3 = S2 + T_BIN, S4 = S3 + T_BOUT, S5 = S4 + T_CIN, S6 = S5 + T_COUT, S7 = S6 + 64 * T_W13, S8 = S7 + 64 * T_W2;
    LAS float* tf = (LAS float*)c.lds + wid * (64 * 65);
    for (int rp = 0; rp < RP_PREP_A; ++rp)
    for (int u = c.bid * 8 + wid; u < S8; u += c.nb * 8) {
        if (u < S1) { const int j = u / T_QKV, t = u % T_QKV; cvt_tile_w(tf, p.in[I_AQKV] + (size_t)j * 1024 * 1536, nullptr, 1536, 1, c.wqkv + (size_t)j * 1536 * 1024, 1024, (t % 24) * 64, (t / 24) * 64, lane); }
        else if (u < S2) { const int v = u - S1, j = v / T_O, t = v % T_O; cvt_tile_w(tf, p.in[I_AO] + (size_t)j * 1024 * 1024, nullptr, 1024, 0, c.wo + (size_t)j * 1024 * 1024, 1024, (t % 16) * 64, (t / 16) * 64, lane); }
        else if (u < S3) { const int t = u - S2; cvt_tile_w(tf, p.in[I_BWIN], nullptr, 2048, 0, c.wbin, 1024, (t % 32) * 64, (t / 32) * 64, lane); }
        else if (u < S4) { const int t = u - S3; cvt_tile_w(tf, p.in[I_BWOUT], nullptr, 1024, 0, c.wbout, 1024, (t % 16) * 64, (t / 16) * 64, lane); }
        else if (u < S5) { const int t = u - S4; cvt_tile_w(tf, p.in[I_CWIN], nullptr, 3072, 0, c.wcin, 1024, (t % 48) * 64, (t / 48) * 64, lane); }
        else if (u < S6) { const int t = u - S5; cvt_tile_w(tf, p.in[I_CWOUT], nullptr, 1024, 0, c.wcout, 1024, (t % 16) * 64, (t / 16) * 64, lane); }
        else if (u < S7) { const int v = u - S6, le = v / T_W13, t = v % T_W13;
            cvt_tile_w(tf, p.in[I_W1] + (size_t)le * 1024 * 512, p.in[I_W3] + (size_t)le * 1024 * 512, 512, 2, c.w13 + (size_t)le * 1024 * 1024, 1024, (t % 16) * 64, (t / 16) * 64, lane); }
        else { const int v = u - S7, le = v / T_W2, t = v % T_W2;
            cvt_tile_w(tf, p.in[I_W2] + (size_t)le * 512 * 1024, nullptr, 1024, 0, c.w2 + (size_t)le * 1024 * 512, 512, (t % 16) * 64, (t / 16) * 64, lane); }
    }
    for (int i = c.bid * NTHREADS + tid; i < 8 * 128 * 128 / 2; i += c.nb * NTHREADS) {
        const float a = p.in[I_BWS][2 * i], b = p.in[I_BWS][2 * i + 1];
        ((unsigned*)c.wbs)[i] = cvt_pk_bf16(a, b);
    }
    __syncthreads();
    LAS float* sl = (LAS float*)c.lds;
    LAS f32x4* red = (LAS f32x4*)(c.lds + 8192);
    for (int j = tid; j < 1024; j += NTHREADS) { sl[j] = silu_f(p.in[I_C][j]); sl[1024 + j] = silu_f(p.in[I_CCTX][j]); }
    __syncthreads();
    for (int rp = 0; rp < RP_PREP_B; ++rp)
    for (int u = c.bid; u < 4 * 24 * 8; u += c.nb) {
        const int layer = u / 192, r = u % 192, cc = r / 8, ks = r % 8;
        const int col = cc * 256 + (tid & 63) * 4, kq = tid >> 6;
        const float* w = p.in[I_WMOD] + (size_t)layer * 1024 * 6144 + (size_t)(ks * 128 + kq * 16) * 6144 + col;
        f32x4 wv[16];
#pragma unroll
        for (int k = 0; k < 16; ++k) wv[k] = *(const f32x4*)(w + (size_t)k * 6144);
        f32x4 a0 = {0.f, 0.f, 0.f, 0.f}, a1 = {0.f, 0.f, 0.f, 0.f};
#pragma unroll
        for (int k = 0; k < 16; ++k) { const float s0 = sl[ks * 128 + kq * 16 + k], s1 = sl[1024 + ks * 128 + kq * 16 + k]; a0 += s0 * wv[k]; a1 += s1 * wv[k]; }
        red[(kq * 64 + (tid & 63)) * 2] = a0; red[(kq * 64 + (tid & 63)) * 2 + 1] = a1;
        __syncthreads();
        if (tid < 128) {
            const int cl = tid & 63, vsel = tid >> 6;
            f32x4 sum = red[cl * 2 + vsel];
#pragma unroll
            for (int q = 1; q < 8; ++q) sum += red[(q * 64 + cl) * 2 + vsel];
            *(f32x4*)(c.modp + (((size_t)layer * 8 + ks) * 2 + vsel) * 6144 + cc * 256 + cl * 4) = sum;
        }
        __syncthreads();
    }
    for (int i = c.bid * NTHREADS + tid; i < 16 * 1024; i += c.nb * NTHREADS) c.rwt[(i & 15) * 1024 + (i >> 4)] = p.in[I_RW][i];
    for (int rp = 0; rp < RP_PREP_C; ++rp)
    for (int i = c.bid * NTHREADS + tid; i < L * 32; i += c.nb * NTHREADS) {
        const int pos = i >> 5, m = i & 31;
        const float freq = powf(10000.0f, -(float)(m & 15) * (1.0f / 16.0f));
        const float ang = (float)((m < 16) ? (pos >> 6) : (pos & 63)) * freq;
        float sn, cs; sincosf(ang, &sn, &cs);
        c.rope[(size_t)pos * 64 + m] = cs;
        c.rope[(size_t)pos * 64 + 32 + m] = sn;
    }
}

__device__ __forceinline__ void phase_mod0(const Ctx& c) {
    PHASE_IDS
    LAS float* mv = (LAS float*)c.lds;
    __syncthreads();
    load_mod(mv, c.modp, c.p.in[I_BMOD], 0, 0, 0); load_mod(mv + 1024, c.modp, c.p.in[I_BMOD], 0, 1, 0);
    load_mod(mv + 2048, c.modp, c.p.in[I_BMOD], 0, 0, 1); load_mod(mv + 3072, c.modp, c.p.in[I_BMOD], 0, 1, 1);
    {
        const int i = c.bid * NTHREADS + tid;
        if (i < 4 * 2 * 6144) {
            const int layer = i / 12288, r = i % 12288, vec = r / 6144, col = r % 6144;
            float sacc = c.p.in[I_BMOD][layer * 6144 + col];
#pragma unroll
            for (int ks = 0; ks < 8; ++ks) sacc += c.modp[(((size_t)layer * 8 + ks) * 2 + vec) * 6144 + col];
            c.modf[i] = sacc;
        }
    }
    __syncthreads();
    const int rpb = T / 256;
    for (int i = wid; i < rpb; i += 8) {
        const int row = c.bid * rpb + i; const bool ic = row >= L;
        const float* xr = ic ? c.p.in[I_CTX] + (size_t)(row - L) * 1024 : c.p.in[I_X] + (size_t)row * 1024;
        LAS float* sh = mv + (ic ? 2048 : 0); LAS float* sc = sh + 1024;
#pragma unroll
        for (int j = 0; j < 4; ++j) {
            const int col = 4 * lane + 256 * j;
            const f32x4 x = *(const f32x4*)(xr + col);
            f32x4 h;
#pragma unroll
            for (int e = 0; e < 4; ++e) h[e] = x[e] * (1.0f + sc[col + e]) + sh[col + e];
            store_bf16x4(c.H + (size_t)row * 1024 + col, h);
        }
    }
}

template <int MODE  >
__device__ __forceinline__ void ctx_gemm(const Ctx& c, const bf16_t* A, const bf16_t* Wt, int N, bf16_t* O, int ldo, const float* bias, int main_units) {
    int tid_ = threadIdx.x; asm volatile("" : "+v"(tid_)); const int tid = tid_, lane = tid & 63, wid = __builtin_amdgcn_readfirstlane(tid >> 6), fr = lane & 15, fq = lane >> 4;
    const int first = main_units % c.nb;
    if (c.bid < first) return;
    constexpr int KC = 512, LDT = KC + 8;
    LAS bf16_t* sA = (LAS bf16_t*)c.lds; LAS bf16_t* sB = sA + 64 * LDT;
    const int nel = c.nb - first, ntile = 4 * (N / 64);
    const int wm = wid >> 1, wn = wid & 1;
    const int lr = tid >> 3, lc = (tid & 7) * 8;
    for (int w = c.bid - first; w < ntile; w += nel) {
        const int r0 = (w & 3) * 64, n0 = (w >> 2) * 64;
        const bf16_t* ap = A + (size_t)(r0 + lr) * 1024 + lc;
        const bf16_t* bp = Wt + (size_t)(n0 + lr) * 1024 + lc;
        f32x4 acc[2];
        acc[0] = (f32x4){0.f, 0.f, 0.f, 0.f}; acc[1] = (f32x4){0.f, 0.f, 0.f, 0.f};
        u32x4 ra[8], rb[8];
#pragma unroll
        for (int j = 0; j < 8; ++j) { ra[j] = *(const u32x4*)(ap + 64 * j); rb[j] = *(const u32x4*)(bp + 64 * j); }
#pragma unroll
        for (int kb = 0; kb < 1024; kb += KC) {
            __syncthreads();
#pragma unroll
            for (int j = 0; j < 8; ++j) { *(LAS u32x4*)(sA + lr * LDT + lc + 64 * j) = ra[j]; *(LAS u32x4*)(sB + lr * LDT + lc + 64 * j) = rb[j]; }
            __syncthreads();
            if (kb + KC < 1024) {
#pragma unroll
                for (int j = 0; j < 8; ++j) { ra[j] = *(const u32x4*)(ap + kb + KC + 64 * j); rb[j] = *(const u32x4*)(bp + kb + KC + 64 * j); }
            }
#pragma unroll
            for (int ks = 0; ks < KC / 32; ++ks) {
                const bf16x8 af = *(const LAS bf16x8*)(sA + (wm * 16 + fr) * LDT + ks * 32 + fq * 8);
                const bf16x8 b0 = *(const LAS bf16x8*)(sB + (wn * 32 + fr) * LDT + ks * 32 + fq * 8);
                const bf16x8 b1 = *(const LAS bf16x8*)(sB + (wn * 32 + 16 + fr) * LDT + ks * 32 + fq * 8);
                acc[0] = __builtin_amdgcn_mfma_f32_16x16x32_bf16(b0, af, acc[0], 0, 0, 0);
                acc[1] = __builtin_amdgcn_mfma_f32_16x16x32_bf16(b1, af, acc[1], 0, 0, 0);
            }
        }
#pragma unroll
        for (int n = 0; n < 2; ++n) {
            const int row = r0 + wm * 16 + fr, col = n0 + wn * 32 + n * 16 + 4 * fq;
            f32x4 v = acc[n];
            if (MODE == 1) { const f32x4 bb = *(const f32x4*)(bias + col);
#pragma unroll
                for (int e = 0; e < 4; ++e) v[e] = gelu_tanh_f(v[e] + bb[e]); }
            store_bf16x4(O + (size_t)row * ldo + col, v);
        }
    }
}

template <int KIND>
__device__ __forceinline__ void phase_g1(const Ctx& c, int j) {
    constexpr int N = KIND == 0 ? 1536 : (KIND == 1 ? 2048 : 3072);
    const bf16_t* W = KIND == 0 ? c.wqkv + (size_t)j * 1536 * 1024 : (KIND == 1 ? c.wbin : c.wcin);
    SchedPlain S{(const char*)c.H, (const char*)W, (size_t)256 * 1024 * 2, L / 256, N / 256, c.nb, c.bid};
    __syncthreads();
    if constexpr (KIND == 0) { E8Qkv e{c.Y1, c.rope}; g8::gemm8<E8Qkv, SchedPlain, false, true>(c.lds, 1024, S, e); }
    else if constexpr (KIND == 1) { E8Gelu e{c.Y1, N, c.p.in[I_BBIN]}; g8::gemm8<E8Gelu, SchedPlain, false, true>(c.lds, 1024, S, e); }
    else { E8Plain e{c.Y1, N}; g8::gemm8<E8Plain, SchedPlain, false, true>(c.lds, 1024, S, e); }
    ctx_gemm<KIND == 1 ? 1 : 0>(c, c.H + (size_t)L * 1024, W, N, c.Y1 + (size_t)L * N, N, c.p.in[I_BBIN], (L / 256) * (N / 256));
}
__device__ __forceinline__ void phase_g2(const Ctx& c, const bf16_t* W, int nrows) {
    SchedPlain S{(const char*)c.MID, (const char*)W, (size_t)256 * 1024 * 2, L / 256, 4, c.nb, c.bid};
    E8Plain e{c.YL, 1024};
    __syncthreads();
    g8::gemm8<E8Plain, SchedPlain, false, true>(c.lds, 1024, S, e);
    if (nrows > L) ctx_gemm<0>(c, c.MID + (size_t)L * 1024, W, 1024, c.YL + (size_t)L * 1024, 1024, nullptr, (L / 256) * 4);
}

__device__ __forceinline__ void phase_attn(const Ctx& c, const float* sink, bool ctxq) {
    PHASE_IDS
    constexpr int KS = 72, VS = 68;
    LAS bf16_t* sK = (LAS bf16_t*)c.lds;
    LAS bf16_t* sVT = sK + 64 * KS;
    const int g = wid >> 1, qh = wid & 1, ql = lane & 31, hi = lane >> 5;
    const int nqb = 256 + (ctxq ? 4 : 0);
    const float SC2 = 0.125f * 1.4426950408889634f;
    const int lkey = tid >> 3, lpc = tid & 7;
    for (int u = c.bid; u < nqb * 4; u += c.nb) {
        const int kvh = u / nqb, qb = u % nqb;
        const bool isctx = qb >= 256;
        const int qrow0 = isctx ? L + (qb - 256) * 64 : qb * 64;
        const int myq = qrow0 + qh * 32 + ql;
        const int head = kvh * 4 + g;
        bf16x8 qf[4];
#pragma unroll
        for (int s = 0; s < 4; ++s) qf[s] = *(const bf16x8*)(c.Y1 + (size_t)myq * QKVW + head * 64 + 16 * s + 8 * hi);
        float m_run = sink[head] * 1.4426950408889634f, l_run = (hi == 0) ? 1.0f : 0.0f;
        f32x16 oacc[2];
#pragma unroll
        for (int r = 0; r < 16; ++r) { oacc[0][r] = 0.f; oacc[1][r] = 0.f; }
        for (int ti = 0; ti < 9; ++ti) {
            int k0;
            if (ti < 5) { k0 = qrow0 - 128 + 64 * ti; if (isctx || k0 < 0 || k0 >= L) continue; }
            else k0 = L + 64 * (ti - 5);
            const u32x4 kr = *(const u32x4*)(c.Y1 + (size_t)(k0 + lkey) * QKVW + 1024 + kvh * 64 + lpc * 8);
            const u32x4 vr = *(const u32x4*)(c.Y1 + (size_t)(k0 + lkey) * QKVW + 1280 + kvh * 64 + lpc * 8);
            __syncthreads();
            *(LAS u32x4*)(sK + lkey * KS + lpc * 8) = kr;
            sVT[(lpc * 8 + 0) * VS + lkey] = (bf16_t)(vr.x & 0xffff); sVT[(lpc * 8 + 1) * VS + lkey] = (bf16_t)(vr.x >> 16);
            sVT[(lpc * 8 + 2) * VS + lkey] = (bf16_t)(vr.y & 0xffff); sVT[(lpc * 8 + 3) * VS + lkey] = (bf16_t)(vr.y >> 16);
            sVT[(lpc * 8 + 4) * VS + lkey] = (bf16_t)(vr.z & 0xffff); sVT[(lpc * 8 + 5) * VS + lkey] = (bf16_t)(vr.z >> 16);
            sVT[(lpc * 8 + 6) * VS + lkey] = (bf16_t)(vr.w & 0xffff); sVT[(lpc * 8 + 7) * VS + lkey] = (bf16_t)(vr.w >> 16);
            __syncthreads();
            f32x16 sacc[2];
#pragma unroll
            for (int r = 0; r < 16; ++r) { sacc[0][r] = 0.f; sacc[1][r] = 0.f; }
#pragma unroll
            for (int ks = 0; ks < 2; ++ks)
#pragma unroll
                for (int s = 0; s < 4; ++s) {
                    const bf16x8 kf = *(const LAS bf16x8*)(sK + (32 * ks + ql) * KS + 16 * s + 8 * hi);
                    sacc[ks] = __builtin_amdgcn_mfma_f32_32x32x16_bf16(kf, qf[s], sacc[ks], 0, 0, 0);
                }
            float mx = -INFINITY;
#pragma unroll
            for (int ks = 0; ks < 2; ++ks)
#pragma unroll
                for (int r = 0; r < 16; ++r) {
                    float v = sacc[ks][r] * SC2;
                    if (ti == 0 || ti == 4) {
                        const int kpos = k0 + 32 * ks + (r & 3) + 8 * (r >> 2) + 4 * hi;
                        const int dlt = kpos - myq;
                        if (dlt < -128 || dlt > 128) v = -INFINITY;
                    }
                    sacc[ks][r] = v; mx = fmaxf(mx, v);
                }
            mx = fmaxf(mx, __shfl_xor(mx, 32));
            const float m_new = fmaxf(m_run, mx);
            const float alpha = exp2f(m_run - m_new);
            m_run = m_new; l_run *= alpha;
#pragma unroll
            for (int r = 0; r < 16; ++r) { oacc[0][r] *= alpha; oacc[1][r] *= alpha; }
            float ls = 0.f;
            bf16x8 pb[2][2];
#pragma unroll
            for (int ks = 0; ks < 2; ++ks)
#pragma unroll
                for (int s2 = 0; s2 < 2; ++s2) {
                    float e[8];
#pragma unroll
                    for (int jj = 0; jj < 8; ++jj) { e[jj] = exp2f(sacc[ks][8 * s2 + jj] - m_new); ls += e[jj]; }
                    u32x4 w; w.x = cvt_pk_bf16(e[0], e[1]); w.y = cvt_pk_bf16(e[2], e[3]); w.z = cvt_pk_bf16(e[4], e[5]); w.w = cvt_pk_bf16(e[6], e[7]);
                    pb[ks][s2] = __builtin_bit_cast(bf16x8, w);
                }
            l_run += ls;
#pragma unroll
            for (int dt = 0; dt < 2; ++dt)
#pragma unroll
                for (int ks = 0; ks < 2; ++ks)
#pragma unroll
                    for (int s2 = 0; s2 < 2; ++s2) {
                        const int kb = 32 * ks + 16 * s2;
                        const u32x2 lo = *(const LAS u32x2*)(sVT + (32 * dt + ql) * VS + kb + 4 * hi);
                        const u32x2 hh = *(const LAS u32x2*)(sVT + (32 * dt + ql) * VS + kb + 8 + 4 * hi);
                        u32x4 w; w.x = lo.x; w.y = lo.y; w.z = hh.x; w.w = hh.y;
                        oacc[dt] = __builtin_amdgcn_mfma_f32_32x32x16_bf16(__builtin_bit_cast(bf16x8, w), pb[ks][s2], oacc[dt], 0, 0, 0);
                    }
        }
        const float lt = l_run + __shfl_xor(l_run, 32);
        const float inv = 1.0f / lt;
#pragma unroll
        for (int dt = 0; dt < 2; ++dt)
#pragma unroll
            for (int rq = 0; rq < 4; ++rq) {
                f32x4 o; o[0] = oacc[dt][4 * rq] * inv; o[1] = oacc[dt][4 * rq + 1] * inv; o[2] = oacc[dt][4 * rq + 2] * inv; o[3] = oacc[dt][4 * rq + 3] * inv;
                store_bf16x4(c.MID + (size_t)myq * 1024 + head * 64 + 32 * dt + 8 * rq + 4 * hi, o);
            }
    }
}

__device__ __forceinline__ void phase_gmlp(const Ctx& c) {
    PHASE_IDS
    constexpr int VS = 136;
    LAS bf16_t* sVT = (LAS bf16_t*)c.lds;
    LAS float* st = (LAS float*)(c.lds + 128 * VS * 2);
    const float* lng = c.p.in[I_BLNG]; const float* lnb = c.p.in[I_BLNB]; const float* bs = c.p.in[I_BBS];
    const int fr = lane & 15, fq = lane >> 4;
    for (int u = c.bid; u < 130 * 8; u += c.nb) {
        const int chunk = u >> 3, g = u & 7;
        const int row0 = chunk < 128 ? chunk * 128 : L + (chunk - 128) * 128;
        __syncthreads();
        for (int i = 0; i < 16; ++i) {
            const int r = wid * 16 + i;
            const bf16_t* vp = c.Y1 + (size_t)(row0 + r) * 2048 + 1024 + lane * 16;
            const u32x4 a = *(const u32x4*)vp, b = *(const u32x4*)(vp + 8);
            float x[16] = {bflo(a.x), bfhi(a.x), bflo(a.y), bfhi(a.y), bflo(a.z), bfhi(a.z), bflo(a.w), bfhi(a.w),
                           bflo(b.x), bfhi(b.x), bflo(b.y), bfhi(b.y), bflo(b.z), bfhi(b.z), bflo(b.w), bfhi(b.w)};
            float s = 0.f;
#pragma unroll
            for (int e = 0; e < 16; ++e) s += x[e];
            const float mean = wave_sum(s) * (1.0f / 1024.0f);
            float q = 0.f;
#pragma unroll
            for (int e = 0; e < 16; ++e) { const float d = x[e] - mean; q += d * d; }
            const float var = wave_sum(q) * (1.0f / 1024.0f);
            if (lane == 0) { st[2 * r] = mean; st[2 * r + 1] = rsqrtf(var + LN_EPS); }
        }
        __syncthreads();
        {
            const int q = tid >> 2;
            const float mean = st[2 * q], rstd = st[2 * q + 1];
#pragma unroll
            for (int i = 0; i < 4; ++i) {
                const int cc = ((tid & 3) * 4 + i) * 8;
                const u32x4 a = *(const u32x4*)(c.Y1 + (size_t)(row0 + q) * 2048 + 1024 + g * 128 + cc);
                const float x[8] = {bflo(a.x), bfhi(a.x), bflo(a.y), bfhi(a.y), bflo(a.z), bfhi(a.z), bflo(a.w), bfhi(a.w)};
#pragma unroll
                for (int e = 0; e < 8; ++e) {
                    const float vn = (x[e] - mean) * rstd * lng[g * 128 + cc + e] + lnb[g * 128 + cc + e];
                    sVT[(cc + e) * VS + q] = (bf16_t)(cvt_pk_bf16(vn, 0.f) & 0xffff);
                }
            }
        }
        __syncthreads();
        const int p0 = (wid >> 1) * 32, c0 = (wid & 1) * 64;
        f32x4 acc[2][4];
#pragma unroll
        for (int m = 0; m < 2; ++m)
#pragma unroll
            for (int n = 0; n < 4; ++n) acc[m][n] = (f32x4){0.f, 0.f, 0.f, 0.f};
#pragma unroll
        for (int ks = 0; ks < 4; ++ks) {
            bf16x8 af[2], bfr[4];
#pragma unroll
            for (int m = 0; m < 2; ++m) af[m] = *(const bf16x8*)(c.wbs + (size_t)(g * 128 + p0 + m * 16 + fr) * 128 + ks * 32 + fq * 8);
#pragma unroll
            for (int n = 0; n < 4; ++n) bfr[n] = *(const LAS bf16x8*)(sVT + (c0 + n * 16 + fr) * VS + ks * 32 + fq * 8);
#pragma unroll
            for (int m = 0; m < 2; ++m)
#pragma unroll
                for (int n = 0; n < 4; ++n) acc[m][n] = __builtin_amdgcn_mfma_f32_16x16x32_bf16(bfr[n], af[m], acc[m][n], 0, 0, 0);
        }
#pragma unroll
        for (int m = 0; m < 2; ++m) {
            const int pp = p0 + m * 16 + fr;
            const float bias = bs[pp * 8 + g];
#pragma unroll
            for (int n = 0; n < 4; ++n) {
                const int cc = g * 128 + c0 + n * 16 + fq * 4;
                const u32x2 uu = *(const u32x2*)(c.Y1 + (size_t)(row0 + pp) * 2048 + cc);
                f32x4 o; o[0] = bflo(uu.x) * (acc[m][n][0] + bias); o[1] = bfhi(uu.x) * (acc[m][n][1] + bias);
                o[2] = bflo(uu.y) * (acc[m][n][2] + bias); o[3] = bfhi(uu.y) * (acc[m][n][3] + bias);
                store_bf16x4(c.MID + (size_t)(row0 + pp) * 1024 + cc, o);
            }
        }
    }
}

__device__ __forceinline__ void phase_conv(const Ctx& c) {
    PHASE_IDS
    const float* wc = c.p.in[I_CWCONV];
    const int ch = lane * 16;
    const int rpb = T / 256;
    for (int i = wid; i < rpb; i += 8) {
        const int row = c.bid * rpb + i;
        const bool hasp = (row != 0) && (row != L), hasn = (row != L - 1) && (row != T - 1);
        float zc[16];
#pragma unroll
        for (int e = 0; e < 16; ++e) zc[e] = 0.f;
#pragma unroll
        for (int t = 0; t < 3; ++t) {
            const bool ok = (t == 1) || (t == 0 ? hasp : hasn);
            if (ok) {
                const bf16_t* rp = c.Y1 + (size_t)(row + t - 1) * 3072;
#pragma unroll
                for (int hv = 0; hv < 2; ++hv) {
                    const u32x4 gcv = *(const u32x4*)(rp + 1024 + ch + hv * 8), zv = *(const u32x4*)(rp + 2048 + ch + hv * 8);
                    const f32x4 w0 = *(const f32x4*)(wc + t * 1024 + ch + hv * 8), w1 = *(const f32x4*)(wc + t * 1024 + ch + hv * 8 + 4);
                    zc[hv * 8 + 0] += w0[0] * bflo(gcv.x) * bflo(zv.x); zc[hv * 8 + 1] += w0[1] * bfhi(gcv.x) * bfhi(zv.x);
                    zc[hv * 8 + 2] += w0[2] * bflo(gcv.y) * bflo(zv.y); zc[hv * 8 + 3] += w0[3] * bfhi(gcv.y) * bfhi(zv.y);
                    zc[hv * 8 + 4] += w1[0] * bflo(gcv.z) * bflo(zv.z); zc[hv * 8 + 5] += w1[1] * bfhi(gcv.z) * bfhi(zv.z);
                    zc[hv * 8 + 6] += w1[2] * bflo(gcv.w) * bflo(zv.w); zc[hv * 8 + 7] += w1[3] * bfhi(gcv.w) * bfhi(zv.w);
                }
            }
        }
        const bf16_t* rp = c.Y1 + (size_t)row * 3072 + ch;
#pragma unroll
        for (int hv = 0; hv < 2; ++hv) {
            const u32x4 gb = *(const u32x4*)(rp + hv * 8);
            u32x4 w;
            w.x = cvt_pk_bf16(bflo(gb.x) * zc[hv * 8 + 0], bfhi(gb.x) * zc[hv * 8 + 1]);
            w.y = cvt_pk_bf16(bflo(gb.y) * zc[hv * 8 + 2], bfhi(gb.y) * zc[hv * 8 + 3]);
            w.z = cvt_pk_bf16(bflo(gb.z) * zc[hv * 8 + 4], bfhi(gb.z) * zc[hv * 8 + 5]);
            w.w = cvt_pk_bf16(bflo(gb.w) * zc[hv * 8 + 6], bfhi(gb.w) * zc[hv * 8 + 7]);
            *(u32x4*)(c.MID + (size_t)row * 1024 + ch + hv * 8) = w;
        }
    }
}

#define LN_LOADROW(XR, YR, xv, yv) do { _Pragma("unroll") for (int j = 0; j < 4; ++j) { xv[j] = *(const f32x4*)((XR) + 4 * lane + 256 * j); yv[j] = *(const u32x2*)((YR) + 4 * lane + 256 * j); } } while (0)
__device__ __forceinline__ void phase_ln1(const Ctx& c, int layer, int nrows) {
    PHASE_IDS
    const Params& p = c.p;
    LAS float* rw = (LAS float*)c.lds;
    LAS float* mv = rw + 16 * 1024;
    LAS float* lg = mv + 6 * 1024;
    LAS int* hist = (LAS int*)(lg + 2 * 1024);
    LAS int* base = hist + 16;
    LAS int* rinfo = base + 16;
    __syncthreads();
    lds_copy(rw, c.rwt, 16 * 1024, tid);
    lds_copy(mv, c.modf + (size_t)(layer * 2 + 0) * 6144 + 2 * 1024, 3 * 1024, tid);
    lds_copy(mv + 3072, c.modf + (size_t)(layer * 2 + 1) * 6144 + 2 * 1024, 3 * 1024, tid);
    lds_copy(lg, p.in[I_LN1G] + layer * 1024, 1024, tid); lds_copy(lg + 1024, p.in[I_LN1B] + layer * 1024, 1024, tid);
    if (tid < 16) hist[tid] = 0;
    __syncthreads();
    const int rpb = nrows / 256;
    const float* xbase = (layer == 0) ? p.in[I_X] : c.X;
    const float* cbase = (layer == 0) ? p.in[I_CTX] - (size_t)L * 1024 : c.X;
    f32x4 xq[4]; u32x2 yq[4];
    if (wid < rpb) { const int row = c.bid * rpb + wid; LN_LOADROW((row >= L ? cbase : xbase) + (size_t)row * 1024, c.YL + (size_t)row * 1024, xq, yq); }
    for (int i = wid; i < rpb; i += 8) {
        const int row = c.bid * rpb + i; const bool ic = row >= L;
        f32x4 xv[4]; u32x2 yv[4];
#pragma unroll
        for (int j = 0; j < 4; ++j) { xv[j] = xq[j]; yv[j] = yq[j]; }
        if (i + 8 < rpb) { const int rn = row + 8; LN_LOADROW((rn >= L ? cbase : xbase) + (size_t)rn * 1024, c.YL + (size_t)rn * 1024, xq, yq); }
        LAS float* ga = mv + (ic ? 3072 : 0); LAS float* shf = ga + 1024; LAS float* scf = ga + 2048;
        float v[16];
        float s = 0.f;
#pragma unroll
        for (int j = 0; j < 4; ++j) {
            const int col = 4 * lane + 256 * j;
            const f32x4 g4 = *(const LAS f32x4*)(ga + col);
            v[4 * j + 0] = ALPHA * xv[j][0] + g4[0] * bflo(yv[j].x); v[4 * j + 1] = ALPHA * xv[j][1] + g4[1] * bfhi(yv[j].x);
            v[4 * j + 2] = ALPHA * xv[j][2] + g4[2] * bflo(yv[j].y); v[4 * j + 3] = ALPHA * xv[j][3] + g4[3] * bfhi(yv[j].y);
            s += (v[4 * j] + v[4 * j + 1]) + (v[4 * j + 2] + v[4 * j + 3]);
        }
        const float mean = wave_sum(s) * (1.0f / 1024.0f);
        float q = 0.f;
#pragma unroll
        for (int e = 0; e < 16; ++e) { const float d = v[e] - mean; q += d * d; }
        const float rstd = rsqrtf(wave_sum(q) * (1.0f / 1024.0f) + LN_EPS);
        float h[16];
#pragma unroll
        for (int j = 0; j < 4; ++j) {
            const int col = 4 * lane + 256 * j;
            const f32x4 lg4 = *(const LAS f32x4*)(lg + col), lb4 = *(const LAS f32x4*)(lg + 1024 + col), sc4 = *(const LAS f32x4*)(scf + col), sh4 = *(const LAS f32x4*)(shf + col);
            f32x4 xn, hh;
#pragma unroll
            for (int e = 0; e < 4; ++e) {
                xn[e] = (v[4 * j + e] - mean) * rstd * lg4[e] + lb4[e];
                hh[e] = xn[e] * (1.0f + sc4[e]) + sh4[e];
                h[4 * j + e] = hh[e];
            }
            *(f32x4*)(c.X + (size_t)row * 1024 + col) = xn;
            store_bf16x4(c.H + (size_t)row * 1024 + col, hh);
        }
        float a[16];
#pragma unroll
        for (int e = 0; e < 16; ++e) {
            float t = 0.f;
#pragma unroll
            for (int j = 0; j < 4; ++j) {
                const f32x4 w = *(const LAS f32x4*)(rw + e * 1024 + 4 * lane + 256 * j);
                t += h[4 * j] * w[0] + h[4 * j + 1] * w[1] + h[4 * j + 2] * w[2] + h[4 * j + 3] * w[3];
            }
            a[e] = t;
        }
        float b8[8], c4[4], d2[2], e1;
        { const bool up = (lane & 32) != 0;
#pragma unroll
          for (int j = 0; j < 8; ++j) { const float snd = up ? a[j] : a[j + 8], kp = up ? a[j + 8] : a[j]; b8[j] = kp + __shfl_xor(snd, 32); } }
        { const bool up = (lane & 16) != 0;
#pragma unroll
          for (int j = 0; j < 4; ++j) { const float snd = up ? b8[j] : b8[j + 4], kp = up ? b8[j + 4] : b8[j]; c4[j] = kp + __shfl_xor(snd, 16); } }
        { const bool up = (lane & 8) != 0;
#pragma unroll
          for (int j = 0; j < 2; ++j) { const float snd = up ? c4[j] : c4[j + 2], kp = up ? c4[j + 2] : c4[j]; d2[j] = kp + __shfl_xor(snd, 8); } }
        { const bool up = (lane & 4) != 0; const float snd = up ? d2[0] : d2[1], kp = up ? d2[1] : d2[0]; e1 = kp + __shfl_xor(snd, 4); }
        e1 += __shfl_xor(e1, 2); e1 += __shfl_xor(e1, 1);
        const float sgl = 1.0f / (1.0f + __expf(-e1));
        float sg[16], ssel[16];
#pragma unroll
        for (int e = 0; e < 16; ++e) { sg[e] = __uint_as_float((unsigned)__builtin_amdgcn_readlane((int)__float_as_uint(sgl), 4 * e)); ssel[e] = sg[e] + p.in[I_RB][e]; }
        float bestgs = -INFINITY;
        int e0 = 0, e1i = 1; float u0 = 0.f, u1 = 0.f;
#pragma unroll
        for (int gq = 0; gq < 4; ++gq) {
            int i0 = 0; float v0 = ssel[4 * gq]; float w0 = sg[4 * gq];
#pragma unroll
            for (int k = 1; k < 4; ++k) if (ssel[4 * gq + k] > v0) { v0 = ssel[4 * gq + k]; i0 = k; w0 = sg[4 * gq + k]; }
            int i1 = -1; float v1 = -INFINITY; float w1 = 0.f;
#pragma unroll
            for (int k = 0; k < 4; ++k) if (k != i0 && ssel[4 * gq + k] > v1) { v1 = ssel[4 * gq + k]; i1 = k; w1 = sg[4 * gq + k]; }
            const float gs = v0 + v1;
            if (gs > bestgs) { bestgs = gs; e0 = 4 * gq + i0; e1i = 4 * gq + i1; u0 = w0; u1 = w1; }
        }
        if (lane == 0) {
            const int r0l = __hip_atomic_fetch_add(&hist[e0], 1, __ATOMIC_RELAXED, __HIP_MEMORY_SCOPE_WORKGROUP);
            const int r1l = __hip_atomic_fetch_add(&hist[e1i], 1, __ATOMIC_RELAXED, __HIP_MEMORY_SCOPE_WORKGROUP);
            rinfo[4 * i + 0] = e0; rinfo[4 * i + 1] = r0l; rinfo[4 * i + 2] = e1i; rinfo[4 * i + 3] = r1l;
            const float inv = 1.0f / (u0 + u1);
            c.asg[(size_t)row * 4 + 2] = __float_as_uint(u0 * inv);
            c.asg[(size_t)row * 4 + 3] = __float_as_uint(u1 * inv);
        }
    }
    __syncthreads();
    if (tid < 16) base[tid] = (int)__hip_atomic_fetch_add(&c.cnt[(layer * 16 + tid) * 32], (unsigned)hist[tid], __ATOMIC_RELAXED, __HIP_MEMORY_SCOPE_AGENT);
    __syncthreads();
    for (int i = tid; i < rpb; i += NTHREADS) {
        const int row = c.bid * rpb + i;
        const int e0 = rinfo[4 * i], s0 = base[e0] + rinfo[4 * i + 1], e1 = rinfo[4 * i + 2], s1 = base[e1] + rinfo[4 * i + 3];
        c.tok[(size_t)e0 * T + s0] = row; c.tok[(size_t)e1 * T + s1] = row;
        c.asg[(size_t)row * 4 + 0] = ((unsigned)e0 << 20) | (unsigned)s0;
        c.asg[(size_t)row * 4 + 1] = ((unsigned)e1 << 20) | (unsigned)s1;
    }
}

__device__ __forceinline__ void moe_tables(const Ctx& c, int layer, LAS int* tb) {
    PHASE_IDS
    __syncthreads();
    if (tid == 0) {
        int acc = 0;
        for (int e = 0; e < 16; ++e) {
            const int n = (int)__hip_atomic_load(&c.cnt[(layer * 16 + e) * 32], __ATOMIC_RELAXED, __HIP_MEMORY_SCOPE_AGENT);
            tb[e] = n; tb[16 + e] = acc; acc += (n + 255) >> 8;
        }
        tb[32] = acc;
    }
    __syncthreads();
}

__device__ __forceinline__ void phase_moe1(const Ctx& c, int layer) {
    LAS int* tb = (LAS int*)(c.lds + TB_OFF);
    moe_tables(c, layer, tb);
    SchedMoe S{(const char*)c.H, 0, (const char*)(c.w13 + (size_t)layer * 16 * 1024 * 1024), (size_t)1024 * 1024 * 2, (size_t)256 * 1024 * 2, c.tok, tb, __builtin_amdgcn_readfirstlane(tb[32]), c.nb, c.bid};
    E8Swiglu e{c.HID};
    g8::gemm8<E8Swiglu, SchedMoe, true, true>(c.lds, 1024, S, e);
}
__device__ __forceinline__ void phase_moe2(const Ctx& c, int layer) {
    LAS int* tb = (LAS int*)(c.lds + TB_OFF);
    moe_tables(c, layer, tb);
    SchedMoe S{(const char*)c.HID, (size_t)256 * DEXP * 2, (const char*)(c.w2 + (size_t)layer * 16 * 1024 * DEXP), (size_t)1024 * DEXP * 2, (size_t)256 * DEXP * 2, c.tok, tb, __builtin_amdgcn_readfirstlane(tb[32]), c.nb, c.bid};
    E8Plain e{c.YS, 1024};
    g8::gemm8<E8Plain, SchedMoe, false, true>(c.lds, DEXP, S, e);
}

#define LN2_LOADROW(ROW, I, xv, y0v, y1v) do { const unsigned _a0 = ainfo[4 * (I)], _a1 = ainfo[4 * (I) + 1]; \
    const size_t _p0 = (size_t)tb[16 + (_a0 >> 20)] * 256 + (_a0 & 0xfffff), _p1 = (size_t)tb[16 + (_a1 >> 20)] * 256 + (_a1 & 0xfffff); \
    _Pragma("unroll") for (int j = 0; j < 4; ++j) { xv[j] = *(const f32x4*)(c.X + (size_t)(ROW) * 1024 + 4 * lane + 256 * j); \
        y0v[j] = *(const u32x2*)(c.YS + _p0 * 1024 + 4 * lane + 256 * j); y1v[j] = *(const u32x2*)(c.YS + _p1 * 1024 + 4 * lane + 256 * j); } } while (0)
__device__ __forceinline__ void phase_ln2(const Ctx& c, int layer, int nrows) {
    PHASE_IDS
    const Params& p = c.p;
    LAS int* tb = (LAS int*)(c.lds + TB_OFF);
    moe_tables(c, layer, tb);
    LAS float* mv = (LAS float*)c.lds;
    LAS float* lg = mv + 6 * 1024;
    LAS unsigned* ainfo = (LAS unsigned*)(lg + 2 * 1024);
    const int rpb = nrows / 256;
    lds_copy(mv, c.modf + (size_t)(layer * 2 + 0) * 6144 + 5 * 1024, 1024, tid); lds_copy(mv + 1024, c.modf + (size_t)(layer * 2 + 1) * 6144 + 5 * 1024, 1024, tid);
    if (layer < 3) { lds_copy(mv + 2048, c.modf + (size_t)((layer + 1) * 2 + 0) * 6144, 2048, tid); lds_copy(mv + 4096, c.modf + (size_t)((layer + 1) * 2 + 1) * 6144, 2048, tid); }
    lds_copy(lg, p.in[I_LN2G] + layer * 1024, 1024, tid); lds_copy(lg + 1024, p.in[I_LN2B] + layer * 1024, 1024, tid);
    for (int i = tid; i < rpb * 4; i += NTHREADS) ainfo[i] = c.asg[(size_t)c.bid * rpb * 4 + i];
    __syncthreads();
    f32x4 xq[4]; u32x2 y0q[4], y1q[4];
    if (wid < rpb) { LN2_LOADROW(c.bid * rpb + wid, wid, xq, y0q, y1q); }
    for (int i = wid; i < rpb; i += 8) {
        const int row = c.bid * rpb + i; const bool ic = row >= L;
        const float g0 = __uint_as_float(ainfo[4 * i + 2]), g1 = __uint_as_float(ainfo[4 * i + 3]);
        f32x4 xv[4]; u32x2 y0[4], y1[4];
#pragma unroll
        for (int j = 0; j < 4; ++j) { xv[j] = xq[j]; y0[j] = y0q[j]; y1[j] = y1q[j]; }
        if (i + 8 < rpb) { LN2_LOADROW(row + 8, i + 8, xq, y0q, y1q); }
        LAS float* gf = mv + (ic ? 1024 : 0);
        float v[16]; float s = 0.f;
#pragma unroll
        for (int j = 0; j < 4; ++j) {
            const int col = 4 * lane + 256 * j;
            const f32x4 g4 = *(const LAS f32x4*)(gf + col);
            v[4 * j + 0] = ALPHA * xv[j][0] + g4[0] * (g0 * bflo(y0[j].x) + g1 * bflo(y1[j].x));
            v[4 * j + 1] = ALPHA * xv[j][1] + g4[1] * (g0 * bfhi(y0[j].x) + g1 * bfhi(y1[j].x));
            v[4 * j + 2] = ALPHA * xv[j][2] + g4[2] * (g0 * bflo(y0[j].y) + g1 * bflo(y1[j].y));
            v[4 * j + 3] = ALPHA * xv[j][3] + g4[3] * (g0 * bfhi(y0[j].y) + g1 * bfhi(y1[j].y));
            s += (v[4 * j] + v[4 * j + 1]) + (v[4 * j + 2] + v[4 * j + 3]);
        }
        const float mean = wave_sum(s) * (1.0f / 1024.0f);
        float q = 0.f;
#pragma unroll
        for (int e = 0; e < 16; ++e) { const float d = v[e] - mean; q += d * d; }
        const float rstd = rsqrtf(wave_sum(q) * (1.0f / 1024.0f) + LN_EPS);
        LAS float* sha = mv + (ic ? 4096 : 2048); LAS float* sca = sha + 1024;
#pragma unroll
        for (int j = 0; j < 4; ++j) {
            const int col = 4 * lane + 256 * j;
            const f32x4 lg4 = *(const LAS f32x4*)(lg + col), lb4 = *(const LAS f32x4*)(lg + 1024 + col);
            f32x4 xn;
#pragma unroll
            for (int e = 0; e < 4; ++e) xn[e] = (v[4 * j + e] - mean) * rstd * lg4[e] + lb4[e];
            if (layer < 3) {
                *(f32x4*)(c.X + (size_t)row * 1024 + col) = xn;
                const f32x4 sc4 = *(const LAS f32x4*)(sca + col), sh4 = *(const LAS f32x4*)(sha + col);
                f32x4 hh;
#pragma unroll
                for (int e = 0; e < 4; ++e) hh[e] = xn[e] * (1.0f + sc4[e]) + sh4[e];
                store_bf16x4(c.H + (size_t)row * 1024 + col, hh);
            } else {
                *(f32x4*)(p.out + (size_t)row * 1024 + col) = xn;
            }
        }
    }
}

constexpr int RP_G = 1, RP_MOE = 1, RP_ATT = 1, RP_MID = 1, RP_PREP = 1, RP_BAR = 1;
#define REP(n, ...) do { for (int _r = 0; _r < (n); ++_r) { __VA_ARGS__; } } while (0)
#define BARR() do { for (int _r = 0; _r < RP_BAR; ++_r) xcd_barrier(bar); } while (0)
template <int LAYER>
__device__ __forceinline__ void layer_fwd(const Ctx& c, const XcdBarrier& bar) {
    constexpr int KIND = LAYER % 3, J = LAYER / 3;
    constexpr bool WANT_CTX = LAYER < DEPTH - 1;
    constexpr int NROWS = WANT_CTX ? T : L;
    phase_g1<KIND>(c, J);
    xcd_barrier(bar);
    if constexpr (KIND == 0) phase_attn(c, c.p.in[I_ASINK] + J * 16, WANT_CTX);
    else if constexpr (KIND == 1) phase_gmlp(c);
    else phase_conv(c);
    xcd_barrier(bar);
    phase_g2(c, KIND == 0 ? c.wo + (size_t)J * 1024 * 1024 : (KIND == 1 ? c.wbout : c.wcout), NROWS);
    xcd_barrier(bar);
    phase_ln1(c, LAYER, NROWS);
    xcd_barrier(bar);
    phase_moe1(c, LAYER);
    xcd_barrier(bar);
    phase_moe2(c, LAYER);
    xcd_barrier(bar);
    phase_ln2(c, LAYER, NROWS);
    if constexpr (LAYER < DEPTH - 1) xcd_barrier(bar);
}

__global__ void __launch_bounds__(NTHREADS, 2) fwd_kernel(Params p) {
    extern __shared__ __attribute__((aligned(16))) unsigned char lds_raw[];
    Ctx c;
    c.p = p; c.lds = (LAS unsigned char*)lds_raw; c.bid = blockIdx.x; c.nb = gridDim.x;
    unsigned char* ws = p.ws; c.ws = ws;
    c.modp = (float*)(ws + WS_MODP); c.modf = (float*)(ws + WS_MODF); c.rwt = (float*)(ws + WS_RWT); c.rope = (float*)(ws + WS_ROPE);
    c.wqkv = (bf16_t*)(ws + WS_WQKV); c.wo = (bf16_t*)(ws + WS_WO); c.wbin = (bf16_t*)(ws + WS_WBIN); c.wbs = (bf16_t*)(ws + WS_WBS); c.wbout = (bf16_t*)(ws + WS_WBOUT);
    c.wcin = (bf16_t*)(ws + WS_WCIN); c.wcout = (bf16_t*)(ws + WS_WCOUT); c.w13 = (bf16_t*)(ws + WS_W13); c.w2 = (bf16_t*)(ws + WS_W2);
    c.X = (float*)(ws + WS_X); c.H = (bf16_t*)(ws + WS_H); c.Y1 = (bf16_t*)(ws + WS_Y1); c.YS = c.Y1; c.MID = (bf16_t*)(ws + WS_MID); c.YL = (bf16_t*)(ws + WS_YL); c.HID = c.MID;
    c.tok = (int*)(ws + WS_TOK); c.asg = (unsigned*)(ws + WS_ASG); c.cnt = (unsigned*)(ws + WS_CTL) + CW_CNT;
    volatile LAS unsigned* bst = (volatile LAS unsigned*)(c.lds + LDS_BYTES - 16);
    if (threadIdx.x == 0) { bst[0] = 0u; bst[1] = 0u; bst[2] = 0u; bst[3] = 0u; }
    __syncthreads();
    XcdBarrier bar = xcd_barrier_post((unsigned*)(ws + WS_CTL), bst);

    phase_prep(c);
    xcd_barrier(bar);
    phase_mod0(c);
    xcd_barrier(bar);
    layer_fwd<0>(c, bar);
    layer_fwd<1>(c, bar);
    layer_fwd<2>(c, bar);
    layer_fwd<3>(c, bar);
}

extern "C" void kernel_launch(void* const* d_in, const int* in_sizes, int n_in, void* d_out, int out_size, void* d_ws, size_t ws_size, hipStream_t stream) {
    static int grid = 0;
    if (grid == 0) {
        if (n_in != 28 || out_size != L * D || ws_size < WS_END) fprintf(stderr, "kernel_launch: unexpected shapes: n_in %d out %d ws %zu (need %zu)\n", n_in, out_size, ws_size, (size_t)WS_END);
        int dev = 0, cus = 0, per_cu = 0;
        if (hipGetDevice(&dev) != hipSuccess || hipDeviceGetAttribute(&cus, hipDeviceAttributeMultiprocessorCount, dev) != hipSuccess) { grid = -1; return; }
        if (hipFuncSetAttribute((const void*)fwd_kernel, hipFuncAttributeMaxDynamicSharedMemorySize, LDS_BYTES) != hipSuccess) { fprintf(stderr, "kernel_launch: hipFuncSetAttribute failed\n"); grid = -1; return; }
        if (hipOccupancyMaxActiveBlocksPerMultiprocessor(&per_cu, (const void*)fwd_kernel, NTHREADS, LDS_BYTES) != hipSuccess || per_cu < 1)
            fprintf(stderr, "kernel_launch: occupancy query reports %d\n", per_cu);
        (void)hipGetLastError();
        grid = cus;
    }
    if (grid < 0) return;
    (void)in_sizes;
    hipMemsetAsync((char*)d_ws + WS_CTL, 0, CTL_BYTES, stream);
    Params p{};
    for (int i = 0; i < 28; ++i) p.in[i] = (const float*)d_in[i];
    p.out = (float*)d_out; p.ws = (unsigned char*)d_ws;
    hipLaunchKernelGGL(fwd_kernel, dim3(grid), dim3(NTHREADS), LDS_BYTES, stream, p);
}
```
